# Optimizing an MI355X kernel written in HIP

```python
import jax, jax.numpy as jnp
from jax import lax
import numpy as np

D_MODEL = 1024
BATCH = 4
SEQ = 8192
DEPTH = 1

CHUNK = 64
D_MIX = D_MODEL
D_MLSTM = D_MIX // 2
N_MLSTM_HEADS = 4
DH_MLSTM = D_MLSTM // N_MLSTM_HEADS
CONV_W = 4
D_GMLP = D_MIX - D_MLSTM
N_GMLP_GROUPS = 8
DG_GMLP = D_GMLP // N_GMLP_GROUPS
GMLP_BLOCK = 128
D_IN = 4 * D_MLSTM + 2 * N_MLSTM_HEADS + 2 * D_GMLP
N_EXPERT_GROUPS = 4
EXPERTS_PER_GROUP = 8
N_EXPERTS = N_EXPERT_GROUPS * EXPERTS_PER_GROUP
TOP_K = 2
D_FF_EXPERT = 512
MOE_BLOCK = 128
EPS = 1e-6

kernel_name = "hymba_mlstm_gmlp_hiermoe"


def rms_norm(x, g):
    xf = x.astype(jnp.float32)
    y = xf * lax.rsqrt(jnp.mean(xf * xf, axis=-1, keepdims=True) + EPS)
    return (y * g.astype(jnp.float32)).astype(x.dtype)


def head_rms(x):
    xf = x.astype(jnp.float32)
    return xf * lax.rsqrt(jnp.mean(xf * xf, axis=-1, keepdims=True) + EPS)


def causal_depthwise_conv(x, w):
    k = w.shape[0]
    s = x.shape[1]
    xp = jnp.pad(x, ((0, 0), (k - 1, 0), (0, 0)))
    y = w[0] * xp[:, 0:s]
    for i in range(1, k):
        y = y + w[i] * xp[:, i:i + s]
    return y


def mlstm_chunkwise(q, k, v, i_pre, f_pre):
    b_, s_, h_, dh = q.shape
    nc = s_ // CHUNK

    def to_chunks(a):
        a = a.reshape((b_, nc, CHUNK, h_) + a.shape[3:])
        return jnp.moveaxis(a, (1, 3), (0, 2))

    log_f = jax.nn.log_sigmoid(f_pre)
    xs = (to_chunks(q), to_chunks(k), to_chunks(v), to_chunks(i_pre), to_chunks(log_f))
    causal = jnp.tril(jnp.ones((CHUNK, CHUNK), dtype=bool))

    def step(carry, inp):
        c_st, n_st, m_st = carry
        qc, kc, vc, ic, lfc = inp
        bcum = jnp.cumsum(lfc, axis=-1)
        d = jnp.where(causal, bcum[..., :, None] - bcum[..., None, :] + ic[..., None, :], -jnp.inf)
        inter = bcum + m_st[..., None]
        m_t = jnp.maximum(inter, jnp.max(d, axis=-1))
        s = jnp.einsum('bhld,bhsd->bhls', qc, kc) * jnp.exp(d - m_t[..., None])
        w_inter = jnp.exp(inter - m_t)
        numer = jnp.einsum('bhls,bhsd->bhld', s, vc) + w_inter[..., None] * jnp.einsum('bhvd,bhld->bhlv', c_st, qc)
        nq = jnp.sum(s, axis=-1) + w_inter * jnp.einsum('bhd,bhld->bhl', n_st, qc)
        h = numer / jnp.maximum(jnp.abs(nq), jnp.exp(-m_t))[..., None]
        b_last = bcum[..., -1]
        w_state = b_last[..., None] - bcum + ic
        m_new = jnp.maximum(b_last + m_st, jnp.max(w_state, axis=-1))
        decay = jnp.exp(b_last + m_st - m_new)
        ws = jnp.exp(w_state - m_new[..., None])
        c_new = decay[..., None, None] * c_st + jnp.einsum('bhl,bhlv,bhld->bhvd', ws, vc, kc)
        n_new = decay[..., None] * n_st + jnp.einsum('bhl,bhld->bhd', ws, kc)
        return (c_new, n_new, m_new), h

    init = (jnp.zeros((b_, h_, dh, dh), jnp.float32), jnp.zeros((b_, h_, dh), jnp.float32),
            jnp.zeros((b_, h_), jnp.float32))
    _, hs = lax.scan(step, init, xs)
    return jnp.moveaxis(hs, (0, 2), (1, 3)).reshape(b_, s_, h_, dh)


def hybrid_mixer(xn, w_in, conv_qk, b_igate, b_fgate, g_mlstm_out, g_gmlp_v, w_spatial, b_spatial, g_gmlp_out, w_out):
    b_, s_, _ = xn.shape
    hh = N_MLSTM_HEADS
    proj = jnp.einsum('bsd,de->bse', xn, w_in)
    cuts = [2 * D_MLSTM, 3 * D_MLSTM, 4 * D_MLSTM, 4 * D_MLSTM + 2 * hh, 4 * D_MLSTM + 2 * hh + D_GMLP]
    qk, v_m, o_pre, if_pre, u_g, v_g = jnp.split(proj, cuts, axis=-1)

    qk = jax.nn.silu(causal_depthwise_conv(qk, conv_qk))
    q, k = jnp.split(qk.astype(jnp.float32), 2, axis=-1)
    q = q.reshape(b_, s_, hh, DH_MLSTM)
    k = k.reshape(b_, s_, hh, DH_MLSTM) * (DH_MLSTM ** -0.5)
    vm = v_m.astype(jnp.float32).reshape(b_, s_, hh, DH_MLSTM)
    i_pre = if_pre[..., :hh].astype(jnp.float32) + b_igate.astype(jnp.float32)
    f_pre = if_pre[..., hh:].astype(jnp.float32) + b_fgate.astype(jnp.float32)
    h_m = mlstm_chunkwise(q, k, vm, i_pre, f_pre)
    h_m = jax.nn.sigmoid(o_pre.astype(jnp.float32)).reshape(b_, s_, hh, DH_MLSTM) * h_m
    y_m = (head_rms(h_m).reshape(b_, s_, D_MLSTM) * g_mlstm_out.astype(jnp.float32)).astype(xn.dtype)

    nb = s_ // GMLP_BLOCK
    u = jax.nn.gelu(u_g)
    vg = rms_norm(jax.nn.gelu(v_g), g_gmlp_v)
    vb = vg.reshape(b_, nb, GMLP_BLOCK, N_GMLP_GROUPS, DG_GMLP)
    tri = jnp.tril(jnp.ones((GMLP_BLOCK, GMLP_BLOCK), dtype=w_spatial.dtype))
    mix = jnp.einsum('gts,bnsgc->bntgc', w_spatial * tri, vb) + b_spatial.T[:, :, None]
    gated = u.reshape(b_, nb, GMLP_BLOCK, N_GMLP_GROUPS, DG_GMLP) * mix
    y_g = (head_rms(gated).reshape(b_, s_, D_GMLP) * g_gmlp_out.astype(jnp.float32)).astype(xn.dtype)

    y = jnp.concatenate([y_m, y_g], axis=-1)
    return jnp.einsum('bse,ed->bsd', y, w_out)


def hierarchical_moe(xn, w_rg, b_rg, w_re, b_re, w_gate, w_up, w_down):
    b_, s_, d = xn.shape
    t = b_ * s_
    xf = xn.reshape(t, d)
    p_g = jax.nn.softmax((xf @ w_rg).astype(jnp.float32) + b_rg.astype(jnp.float32), axis=-1)
    g_sel = jnp.argmax(p_g, axis=-1)
    p_gsel = jnp.take_along_axis(p_g, g_sel[:, None], axis=-1)[:, 0]
    le = ((xf @ w_re).astype(jnp.float32) + b_re.astype(jnp.float32)).reshape(t, N_EXPERT_GROUPS, EXPERTS_PER_GROUP)
    le = jnp.take_along_axis(le, g_sel[:, None, None], axis=1)[:, 0]
    top_p, top_i = lax.top_k(jax.nn.softmax(le, axis=-1), TOP_K)
    top_p = top_p / jnp.sum(top_p, axis=-1, keepdims=True)
    weights = p_gsel[:, None] * top_p
    experts = (g_sel[:, None] * EXPERTS_PER_GROUP + top_i).astype(jnp.int32)

    n_pairs = t * TOP_K
    e_flat = experts.reshape(-1)
    tok_flat = jnp.repeat(jnp.arange(t, dtype=jnp.int32), TOP_K)
    w_flat = weights.reshape(-1)
    order = jnp.argsort(e_flat)
    e_sorted = e_flat[order]
    counts = jnp.zeros((N_EXPERTS,), jnp.int32).at[e_flat].add(1)
    padded = (counts + MOE_BLOCK - 1) // MOE_BLOCK * MOE_BLOCK
    starts = jnp.cumsum(counts) - counts
    pad_ends = jnp.cumsum(padded)
    pad_starts = pad_ends - padded
    dest = pad_starts[e_sorted] + jnp.arange(n_pairs, dtype=jnp.int32) - starts[e_sorted]
    n_blocks = n_pairs // MOE_BLOCK + N_EXPERTS
    n_rows = n_blocks * MOE_BLOCK
    row_tok = jnp.full((n_rows,), t, jnp.int32).at[dest].set(tok_flat[order])
    row_w = jnp.zeros((n_rows,), jnp.float32).at[dest].set(w_flat[order])
    block_e = jnp.minimum(jnp.searchsorted(pad_ends, jnp.arange(n_blocks, dtype=jnp.int32) * MOE_BLOCK, side='right'),
                          N_EXPERTS - 1)
    x_pad = jnp.concatenate([xf, jnp.zeros((1, d), xf.dtype)], axis=0)
    xb = x_pad[row_tok].reshape(n_blocks, MOE_BLOCK, d)

    def expert_block(args):
        xblk, e = args
        hid = jax.nn.silu(xblk @ w_gate[e]) * (xblk @ w_up[e])
        return hid @ w_down[e]

    yb = lax.map(expert_block, (xb, block_e)).reshape(n_rows, d)
    y = jax.ops.segment_sum(yb * row_w[:, None].astype(yb.dtype), row_tok, num_segments=t + 1)[:t]
    return y.reshape(b_, s_, d)


def setup_inputs(seed: int = 0) -> dict:
    key = jax.random.key(seed)
    ks = jax.random.split(key, 20)
    f32 = jnp.float32
    nrm = lambda k, shape, scale: jax.random.normal(k, shape, f32) * scale
    return {
        "x": nrm(ks[0], (BATCH, SEQ, D_MODEL), 1.0),
        "norm1_g": 1.0 + nrm(ks[1], (DEPTH, D_MODEL), 0.02),
        "w_in": nrm(ks[2], (DEPTH, D_MODEL, D_IN), D_MODEL ** -0.5),
        "conv_qk": nrm(ks[3], (DEPTH, CONV_W, 2 * D_MLSTM), CONV_W ** -0.5),
        "b_igate": nrm(ks[4], (DEPTH, N_MLSTM_HEADS), 0.1),
        "b_fgate": jnp.linspace(3.0, 6.0, N_MLSTM_HEADS, dtype=f32)[None, :] + nrm(ks[5], (DEPTH, N_MLSTM_HEADS), 0.1),
        "g_mlstm_out": 1.0 + nrm(ks[6], (DEPTH, D_MLSTM), 0.02),
        "g_gmlp_v": 1.0 + nrm(ks[7], (DEPTH, D_GMLP), 0.02),
        "w_spatial": nrm(ks[8], (DEPTH, N_GMLP_GROUPS, GMLP_BLOCK, GMLP_BLOCK), 0.5 * GMLP_BLOCK ** -0.5),
        "b_spatial": 1.0 + nrm(ks[9], (DEPTH, N_GMLP_GROUPS, GMLP_BLOCK), 0.01),
        "g_gmlp_out": 1.0 + nrm(ks[10], (DEPTH, D_GMLP), 0.02),
        "w_out": nrm(ks[11], (DEPTH, D_MIX, D_MODEL), D_MIX ** -0.5),
        "norm2_g": 1.0 + nrm(ks[12], (DEPTH, D_MODEL), 0.02),
        "w_router_group": nrm(ks[13], (DEPTH, D_MODEL, N_EXPERT_GROUPS), D_MODEL ** -0.5),
        "b_router_group": nrm(ks[14], (DEPTH, N_EXPERT_GROUPS), 0.01),
        "w_router_expert": nrm(ks[15], (DEPTH, D_MODEL, N_EXPERTS), D_MODEL ** -0.5),
        "b_router_expert": nrm(ks[16], (DEPTH, N_EXPERTS), 0.01),
        "w_gate": nrm(ks[17], (DEPTH, N_EXPERTS, D_MODEL, D_FF_EXPERT), D_MODEL ** -0.5),
        "w_up": nrm(ks[18], (DEPTH, N_EXPERTS, D_MODEL, D_FF_EXPERT), D_MODEL ** -0.5),
        "w_down": nrm(ks[19], (DEPTH, N_EXPERTS, D_FF_EXPERT, D_MODEL), D_FF_EXPERT ** -0.5),
        "final_g": 1.0 + nrm(jax.random.fold_in(key, 99), (D_MODEL,), 0.02),
    }


def reference(x, norm1_g, w_in, conv_qk, b_igate, b_fgate, g_mlstm_out, g_gmlp_v, w_spatial, b_spatial,
              g_gmlp_out, w_out, norm2_g, w_router_group, b_router_group, w_router_expert, b_router_expert,
              w_gate, w_up, w_down, final_g):
    h = x
    for l in range(DEPTH):
        h = h + hybrid_mixer(rms_norm(h, norm1_g[l]), w_in[l], conv_qk[l], b_igate[l], b_fgate[l],
                             g_mlstm_out[l], g_gmlp_v[l], w_spatial[l], b_spatial[l], g_gmlp_out[l], w_out[l])
        h = h + hierarchical_moe(rms_norm(h, norm2_g[l]), w_router_group[l], b_router_group[l],
                                 w_router_expert[l], b_router_expert[l], w_gate[l], w_up[l], w_down[l])
    return rms_norm(h, final_g)
```

```cpp
#include <hip/hip_runtime.h>
#include <cstdio>
#include <cstdint>

#ifndef MK_N_LAUNCHES
#define MK_N_LAUNCHES 1
#endif

#ifndef MK_DBG_TELE
#define MK_DBG_TELE 0
#endif
#ifndef MK_DBG_MOE
#define MK_DBG_MOE 1.0f
#endif
#define LAS __attribute__((address_space(3)))
typedef unsigned short bf16_t;
typedef short bf16x8 __attribute__((ext_vector_type(8)));
typedef float f32x4 __attribute__((ext_vector_type(4)));
typedef float f32x2 __attribute__((ext_vector_type(2)));
typedef unsigned u32x4 __attribute__((ext_vector_type(4)));
typedef unsigned u32x2 __attribute__((ext_vector_type(2)));

constexpr int T = 32768, D = 1024, SEQ = 8192, NPROJ = 3072, DIN = 3080;
constexpr int NE = 32, DFF = 512, CAP = 65536;
constexpr float EPS = 1e-6f;
constexpr int NWAVES = 8;

constexpr size_t MiB = 1u << 20;
constexpr size_t WS_CTL = 0, CTL_ZERO_BYTES = 256 * 1024;
constexpr size_t WS_IFP = 1 * MiB;
constexpr size_t WS_CHSC = 2 * MiB;
constexpr size_t WS_MST = 2 * MiB + 65536;
constexpr size_t WS_NST = 3 * MiB;
constexpr size_t WS_HSQ = 4 * MiB;
constexpr size_t WS_WR = 6 * MiB;
constexpr size_t WS_WSP = 6 * MiB + 512 * 1024;
constexpr size_t WS_LIST = 8 * MiB;
constexpr size_t WS_SRSTD = 16 * MiB;
constexpr size_t WS_SW = 24 * MiB;
constexpr size_t WS_WIN = 32 * MiB;
constexpr size_t WS_WOUT = 38 * MiB;
constexpr size_t WS_WGU = 40 * MiB;
constexpr size_t WS_WD = 104 * MiB;
constexpr size_t WS_XN = 136 * MiB;
constexpr size_t WS_Y = 136 * MiB;
constexpr size_t WS_PROJ = 200 * MiB;
constexpr size_t WS_YE = 200 * MiB;
constexpr size_t WS_HB = 328 * MiB;
constexpr size_t WS_CST = 392 * MiB;
constexpr size_t WS_HID = 392 * MiB;
constexpr size_t WS_END = 464 * MiB;
constexpr int CW_GCNT = 64;
constexpr int CW_BAR = 4096;

constexpr int RING_BYTES = 131072;
constexpr int TBL_OFF = RING_BYTES;
constexpr int MISC_OFF = RING_BYTES + 1024;
constexpr int LDS_BYTES = 147456;

typedef __bf16 bf16x2_t __attribute__((ext_vector_type(2)));
__device__ __forceinline__ unsigned cvt_pk_bf16(float lo, float hi) { f32x2 v = {lo, hi}; bf16x2_t b = __builtin_convertvector(v, bf16x2_t); return __builtin_bit_cast(unsigned, b); }
__device__ __forceinline__ unsigned f2bf(float f) { unsigned u = __builtin_bit_cast(unsigned, f); return (u + 0x7fffu + ((u >> 16) & 1u)) >> 16; }
__device__ __forceinline__ float bflo(unsigned w) { return __builtin_bit_cast(float, w << 16); }
__device__ __forceinline__ float bfhi(unsigned w) { return __builtin_bit_cast(float, w & 0xffff0000u); }
__device__ __forceinline__ float sigmoid_f(float x) { return 1.0f / (1.0f + __expf(-x)); }
__device__ __forceinline__ float silu_f(float x) { return x / (1.0f + __expf(-x)); }
__device__ __forceinline__ float gelu_f(float x) { const float u = 0.7978845608028654f * (x + 0.044715f * x * x * x); return x / (1.0f + __expf(-2.0f * u)); }
__device__ __forceinline__ void unpack8(const u32x4 r, float (&v)[8]) { v[0] = bflo(r.x); v[1] = bfhi(r.x); v[2] = bflo(r.y); v[3] = bfhi(r.y); v[4] = bflo(r.z); v[5] = bfhi(r.z); v[6] = bflo(r.w); v[7] = bfhi(r.w); }
__device__ __forceinline__ float wave_sum(float v) {
#pragma unroll
    for (int o = 1; o < 64; o <<= 1) v += __shfl_xor(v, o);
    return v;
}
__device__ __forceinline__ float wave_max(float v) {
#pragma unroll
    for (int o = 1; o < 64; o <<= 1) v = fmaxf(v, __shfl_xor(v, o));
    return v;
}
#define MFMA16(a, b, c) __builtin_amdgcn_mfma_f32_16x16x32_bf16((a), (b), (c), 0, 0, 0)
#define LDS_WAIT() asm volatile("s_waitcnt lgkmcnt(0)" ::: "memory")
#define VM_WAIT() asm volatile("s_waitcnt vmcnt(0)" ::: "memory")

namespace pg8 {
constexpr int BM = 256, BK = 64, HALF = 128, HTB = HALF * BK * 2, STAGE_BYTES = 8 * HTB, NXCD = 8, WGM = 8;
__host__ __device__ __forceinline__ int lds_byte(int r, int c) { const int st = (r >> 4) * 2 + (c >> 5), rr = r & 15, cc = c & 31, ob = rr * 64 + cc * 2; return st * 1024 + (ob ^ (((ob >> 9) & 1) << 5)); }
__host__ __device__ __forceinline__ void stage_rc(int b, int& R, int& C) { const int st = b / 1024, sb = b % 1024, swz = sb ^ (((sb >> 9) & 1) << 5); R = (st >> 1) * 16 + swz / 64; C = (st & 1) * 32 + (swz % 64) / 2; }
__host__ __device__ __forceinline__ int perm32(int rho) { const int n = rho >> 4, i = rho & 15; return 8 * (i >> 2) + 4 * n + (i & 3); }

struct Unit { int pm, pn, lbase, nvalid; };
struct Gemm { const bf16_t* A; const bf16_t* Bt; int M, N, K; const unsigned* list; };

struct StaticOrder {
    int nM, nN, nwg, G, c;
    __device__ void init(int M, int N, int G_, int c_) { nM = M / BM; nN = N / BM; nwg = nM * nN; G = G_; c = c_; }
    __device__ bool next(int i, Unit& u) const {
        const long L = (long)i * G + c; if (L >= nwg) return false;
        int wgid = (int)L; { const int q = nwg / NXCD, r = nwg % NXCD, xcd = wgid % NXCD, off = wgid / NXCD; wgid = (xcd < r ? xcd * (q + 1) : r * (q + 1) + (xcd - r) * q) + off; }
        const int nig = WGM * nN, gid = wgid / nig, fm = gid * WGM, gsz = (nM - fm) < WGM ? (nM - fm) : WGM;
        u.pm = fm + ((wgid % nig) % gsz); u.pn = (wgid % nig) / gsz; u.lbase = 0; u.nvalid = 256; return true;
    }
};
struct MoeOrder {
    const LAS int* tbl; int nunits, G, c;
    __device__ bool next(int i, Unit& u) const {
        const long L = (long)i * G + c; if (L >= nunits) return false;
        int wgid = (int)L; { const int q = nunits / NXCD, r = nunits % NXCD, xcd = wgid % NXCD, off = wgid / NXCD; wgid = (xcd < r ? xcd * (q + 1) : r * (q + 1) + (xcd - r) * q) + off; }
        const int mt = wgid >> 2, pn = wgid & 3;
        int e = 0;
#pragma unroll
        for (int s = 16; s >= 1; s >>= 1) if (tbl[e + s] <= mt) e += s;
        const int lt = mt - tbl[e]; const int rem = tbl[33 + e] - lt * 256;
        u.pm = mt; u.pn = e * 4 + pn; u.lbase = e * CAP + lt * 256; u.nvalid = rem < 256 ? rem : 256; return true;
    }
};

struct EpiP1 {
    static constexpr bool PERM = true;
    bf16_t* O;
    __device__ __forceinline__ void operator()(const f32x4 (&acc)[2][2][4][2], const Unit& u, int wr, int wc, int fr, int fq) const {
        const int act = (u.pn < 6) ? 0 : (u.pn < 8 ? 1 : 2);
        const int row0 = u.pm * BM + wr * 64 + fr, col0 = u.pn * BM + wc * 32 + 8 * fq;
#pragma unroll
        for (int ai = 0; ai < 2; ++ai)
#pragma unroll
            for (int m = 0; m < 4; ++m) { bf16_t* rowp = O + (size_t)(row0 + ai * HALF + m * 16) * NPROJ + col0;
#pragma unroll
                for (int bj = 0; bj < 2; ++bj) { f32x4 v0 = acc[ai][bj][m][0], v1 = acc[ai][bj][m][1];
                    if (act == 1) {
#pragma unroll
                        for (int j = 0; j < 4; ++j) { v0[j] = sigmoid_f(v0[j]); v1[j] = sigmoid_f(v1[j]); }
                    } else if (act == 2) {
#pragma unroll
                        for (int j = 0; j < 4; ++j) { v0[j] = gelu_f(v0[j]); v1[j] = gelu_f(v1[j]); }
                    }
                    u32x4 w; w.x = cvt_pk_bf16(v0[0], v0[1]); w.y = cvt_pk_bf16(v0[2], v0[3]); w.z = cvt_pk_bf16(v1[0], v1[1]); w.w = cvt_pk_bf16(v1[2], v1[3]);
                    *(u32x4*)(rowp + bj * HALF) = w; } }
    }
};
struct EpiP5 {
    static constexpr bool PERM = true;
    const float* X; bf16_t* HB; float* HSQ;
    __device__ __forceinline__ void operator()(const f32x4 (&acc)[2][2][4][2], const Unit& u, int wr, int wc, int fr, int fq) const {
        const int row0 = u.pm * BM + wr * 64 + fr, col0 = u.pn * BM + wc * 32 + 8 * fq;
#pragma unroll
        for (int ai = 0; ai < 2; ++ai)
#pragma unroll
            for (int m = 0; m < 4; ++m) { const int row = row0 + ai * HALF + m * 16; float ss = 0.f;
#pragma unroll
                for (int bj = 0; bj < 2; ++bj) { const size_t off = (size_t)row * D + col0 + bj * HALF;
                    const f32x4 x0 = *(const f32x4*)(X + off), x1 = *(const f32x4*)(X + off + 4);
                    const f32x4 h0 = acc[ai][bj][m][0] + x0, h1 = acc[ai][bj][m][1] + x1;
                    ss += (h0[0] * h0[0] + h0[1] * h0[1]) + (h0[2] * h0[2] + h0[3] * h0[3]) + (h1[0] * h1[0] + h1[1] * h1[1]) + (h1[2] * h1[2] + h1[3] * h1[3]);
                    u32x4 w; w.x = cvt_pk_bf16(h0[0], h0[1]); w.y = cvt_pk_bf16(h0[2], h0[3]); w.z = cvt_pk_bf16(h1[0], h1[1]); w.w = cvt_pk_bf16(h1[2], h1[3]);
                    *(u32x4*)(HB + off) = w; }
                ss += __shfl_xor(ss, 16); ss += __shfl_xor(ss, 32);
                if (fq == 0) HSQ[(size_t)row * 16 + u.pn * 4 + wc] = ss; }
    }
};
struct EpiGU {
    static constexpr bool PERM = true;
    const float* SRSTD; bf16_t* HID;
    __device__ __forceinline__ void operator()(const f32x4 (&acc)[2][2][4][2], const Unit& u, int wr, int wc, int fr, int fq) const {
        const int col0 = (u.pn & 3) * 128 + wc * 32 + 8 * fq;
#pragma unroll
        for (int ai = 0; ai < 2; ++ai)
#pragma unroll
            for (int m = 0; m < 4; ++m) { const int lr = ai * HALF + wr * 64 + m * 16 + fr;
                const float rs = (lr < u.nvalid) ? SRSTD[u.lbase + lr] : 0.f;
                float hv[8];
#pragma unroll
                for (int n = 0; n < 2; ++n)
#pragma unroll
                    for (int j = 0; j < 4; ++j) { const float g = acc[ai][0][m][n][j] * rs, up = acc[ai][1][m][n][j] * rs; hv[n * 4 + j] = silu_f(g) * up; }
                u32x4 w; w.x = cvt_pk_bf16(hv[0], hv[1]); w.y = cvt_pk_bf16(hv[2], hv[3]); w.z = cvt_pk_bf16(hv[4], hv[5]); w.w = cvt_pk_bf16(hv[6], hv[7]);
                *(u32x4*)(HID + (size_t)(u.pm * BM + lr) * DFF + col0) = w; }
    }
};
struct EpiDown {
    static constexpr bool PERM = true;
    const unsigned* LIST; const float* SW; bf16_t* YE;
    __device__ __forceinline__ void operator()(const f32x4 (&acc)[2][2][4][2], const Unit& u, int wr, int wc, int fr, int fq) const {
        const int col0 = (u.pn & 3) * BM + wc * 32 + 8 * fq;
#pragma unroll
        for (int ai = 0; ai < 2; ++ai)
#pragma unroll
            for (int m = 0; m < 4; ++m) { const int lr = ai * HALF + wr * 64 + m * 16 + fr;
                if (lr < u.nvalid) { const unsigned pair = LIST[u.lbase + lr]; const float w8 = SW[u.lbase + lr];
                    bf16_t* rowp = YE + (size_t)pair * D + col0;
#pragma unroll
                    for (int bj = 0; bj < 2; ++bj) { const f32x4 v0 = acc[ai][bj][m][0] * w8, v1 = acc[ai][bj][m][1] * w8;
                        u32x4 w; w.x = cvt_pk_bf16(v0[0], v0[1]); w.y = cvt_pk_bf16(v0[2], v0[3]); w.z = cvt_pk_bf16(v1[0], v1[1]); w.w = cvt_pk_bf16(v1[2], v1[3]);
                        *(u32x4*)(rowp + bj * HALF) = w; } } }
    }
};

template <class Epi, class Sched, bool GATHER>
__device__ __forceinline__ void gemm_phase(LAS unsigned char* lds, const Gemm g, const Sched& S, const Epi& E) {
    const int tid = threadIdx.x, wid = __builtin_amdgcn_readfirstlane(tid >> 6), lane = tid & 63, wr = wid >> 2, wc = wid & 3, fr = lane & 15, fq = lane >> 4;
    const int K = g.K, nt = K / BK;
    unsigned voffB[2], vAc[2][2], vAn[2][2]; int sR[2], sC[2];
    const size_t kstep = (size_t)(BK * 2);
    const size_t hstep = (size_t)HALF * K * 2;
    const size_t tstep = 2 * hstep;
#pragma unroll
    for (int i = 0; i < 2; ++i) { int R, C; stage_rc(tid * 16 + i * 8192, R, C); const int Rb = Epi::PERM ? ((R & ~31) + perm32(R & 31)) : R;
        sR[i] = R; sC[i] = C; voffB[i] = (unsigned)(Rb * K + C) * 2u;
        vAc[0][i] = (unsigned)(R * K + C) * 2u; vAc[1][i] = vAc[0][i] + (unsigned)hstep; vAn[0][i] = vAc[0][i]; vAn[1][i] = vAc[1][i]; }
    const unsigned ldsw = (unsigned)wid * 1024u;
    const int aoff = lds_byte(wr * 64 + fr, fq * 8), boff = lds_byte(wc * 32 + fr, fq * 8);
#define PG8_SA(b, h) (((b) * 2 + (h)) * HTB)
#define PG8_SB(b, h) ((4 + (b) * 2 + (h)) * HTB)
#define PG8_STAGE(bufoff, gbase, voff) do { _Pragma("unroll") for (int _i = 0; _i < 2; ++_i) \
        __builtin_amdgcn_global_load_lds((const unsigned*)((const char*)(gbase) + (voff)[_i]), (LAS unsigned*)(lds + (bufoff) + ldsw + _i * 8192), 16, 0, 0); } while (0)
#define PG8_LDA(dst, b, h) do { _Pragma("unroll") for (int m = 0; m < 4; ++m) _Pragma("unroll") for (int k = 0; k < 2; ++k) dst[m][k] = *(const LAS bf16x8*)(lds + PG8_SA(b, h) + aoff + m * 2048 + k * 1024); } while (0)
#define PG8_LDB(dst, b, h) do { _Pragma("unroll") for (int n = 0; n < 2; ++n) _Pragma("unroll") for (int k = 0; k < 2; ++k) dst[n][k] = *(const LAS bf16x8*)(lds + PG8_SB(b, h) + boff + n * 2048 + k * 1024); } while (0)
#define PG8_MMA(ai, bj, At, Bt) do { __builtin_amdgcn_s_setprio(1); _Pragma("unroll") for (int m = 0; m < 4; ++m) _Pragma("unroll") for (int n = 0; n < 2; ++n) _Pragma("unroll") for (int k = 0; k < 2; ++k) \
        acc[ai][bj][m][n] = __builtin_amdgcn_mfma_f32_16x16x32_bf16(Bt[n][k], At[m][k], acc[ai][bj][m][n], 0, 0, 0); __builtin_amdgcn_s_setprio(0); } while (0)
#define PG8_WAIT_V(n) asm volatile("s_waitcnt vmcnt(" #n ")" ::: "memory")
#define PG8_WAIT_L(n) asm volatile("s_waitcnt lgkmcnt(" #n ")" ::: "memory")
#define PG8_BAR __builtin_amdgcn_s_barrier()
#define PG8_SCHED __builtin_amdgcn_sched_barrier(0)
#define PG8_GATHER(dst, un) do { _Pragma("unroll") for (int _h = 0; _h < 2; ++_h) _Pragma("unroll") for (int _i = 0; _i < 2; ++_i) { \
        const int _lr = _h * HALF + sR[_i]; unsigned _p = 0u; if (_lr < (un).nvalid) _p = g.list[(un).lbase + _lr]; \
        dst[_h][_i] = ((_p >> 1) * (unsigned)K + (unsigned)sC[_i]) * 2u; asm volatile("" : "+v"(dst[_h][_i])); } } while (0)
    Unit cur, nxt; int ui = 0;
    if (!S.next(0, cur)) return;
    f32x4 acc[2][2][4][2];
#pragma unroll
    for (int a = 0; a < 2; ++a)
#pragma unroll
        for (int b = 0; b < 2; ++b)
#pragma unroll
            for (int m = 0; m < 4; ++m)
#pragma unroll
                for (int n = 0; n < 2; ++n) acc[a][b][m][n] = (f32x4){0.f, 0.f, 0.f, 0.f};
    bf16x8 At[4][2], B0[2][2], B1[2][2];
    const char* cA = GATHER ? (const char*)g.A : (const char*)g.A + (size_t)cur.pm * tstep; const char* cB = (const char*)g.Bt + (size_t)cur.pn * tstep;
    if constexpr (GATHER) { PG8_GATHER(vAc, cur); }
    PG8_STAGE(PG8_SB(0, 0), cB, voffB); PG8_STAGE(PG8_SB(0, 1), cB + hstep, voffB); PG8_STAGE(PG8_SA(0, 0), cA, vAc[0]); PG8_STAGE(PG8_SA(0, 1), cA, vAc[1]);
    if (wr == 1) PG8_BAR;
    PG8_WAIT_V(2); PG8_BAR;
    PG8_STAGE(PG8_SB(1, 0), cB + kstep, voffB); PG8_STAGE(PG8_SA(1, 0), cA + kstep, vAc[0]); PG8_STAGE(PG8_SB(1, 1), cB + hstep + kstep, voffB);
    PG8_WAIT_V(6); PG8_BAR;
    for (;;) {
        const bool has_next = S.next(ui + 1, nxt);
        const char* nA = has_next ? (GATHER ? (const char*)g.A : (const char*)g.A + (size_t)nxt.pm * tstep) : cA; const char* nB = has_next ? (const char*)g.Bt + (size_t)nxt.pn * tstep : cB;
        if constexpr (GATHER) {
            if (has_next) { PG8_GATHER(vAn, nxt); }
            else {
#pragma unroll
                for (int h = 0; h < 2; ++h)
#pragma unroll
                    for (int i = 0; i < 2; ++i) vAn[h][i] = vAc[h][i];
            }
        }
        for (int t = 0; t < nt; t += 2) {
            const bool last = (t == nt - 2);
            const char* a1 = cA + (size_t)(t + 1) * kstep;
            const char* a2 = last ? nA : cA + (size_t)(t + 2) * kstep; const char* b2 = last ? nB : cB + (size_t)(t + 2) * kstep;
            const char* a3 = a2 + kstep; const char* b3 = b2 + kstep;
            unsigned vA2[2][2];
#pragma unroll
            for (int h = 0; h < 2; ++h)
#pragma unroll
                for (int i = 0; i < 2; ++i) vA2[h][i] = (GATHER && last) ? vAn[h][i] : vAc[h][i];
            PG8_LDB(B0, 0, 0); PG8_LDB(B1, 0, 1); PG8_SCHED; PG8_LDA(At, 0, 0); PG8_STAGE(PG8_SA(1, 1), a1, vAc[1]);
            PG8_WAIT_V(8); PG8_WAIT_L(0); PG8_BAR; PG8_MMA(0, 0, At, B0); PG8_MMA(0, 1, At, B1); PG8_BAR; PG8_SCHED;
            PG8_LDA(At, 0, 1); PG8_STAGE(PG8_SB(0, 0), b2, voffB); PG8_STAGE(PG8_SB(0, 1), b2 + hstep, voffB); PG8_STAGE(PG8_SA(0, 0), a2, vA2[0]);
            PG8_WAIT_V(8); PG8_WAIT_L(0); PG8_BAR; PG8_MMA(1, 0, At, B0); PG8_MMA(1, 1, At, B1); PG8_BAR; PG8_SCHED;
            PG8_LDB(B0, 1, 0); PG8_LDB(B1, 1, 1); PG8_SCHED; PG8_LDA(At, 1, 0); PG8_STAGE(PG8_SA(0, 1), a2, vA2[1]);
            PG8_WAIT_V(8); PG8_WAIT_L(0); PG8_BAR; PG8_MMA(0, 0, At, B0); PG8_MMA(0, 1, At, B1); PG8_BAR; PG8_SCHED;
            PG8_LDA(At, 1, 1); PG8_STAGE(PG8_SB(1, 0), b3, voffB); PG8_STAGE(PG8_SB(1, 1), b3 + hstep, voffB); PG8_STAGE(PG8_SA(1, 0), a3, vA2[0]);
            PG8_WAIT_V(8); PG8_WAIT_L(0); PG8_BAR; PG8_MMA(1, 0, At, B0); PG8_MMA(1, 1, At, B1); PG8_BAR; PG8_SCHED;
        }
        if (wr == 0) PG8_BAR;
        E(acc, cur, wr, wc, fr, fq);
        if (!has_next) break;
#pragma unroll
        for (int a = 0; a < 2; ++a)
#pragma unroll
            for (int b = 0; b < 2; ++b)
#pragma unroll
                for (int m = 0; m < 4; ++m)
#pragma unroll
                    for (int n = 0; n < 2; ++n) acc[a][b][m][n] = (f32x4){0.f, 0.f, 0.f, 0.f};
        cur = nxt; cA = nA; cB = nB; ++ui;
        if constexpr (GATHER) {
#pragma unroll
            for (int h = 0; h < 2; ++h)
#pragma unroll
                for (int i = 0; i < 2; ++i) vAc[h][i] = vAn[h][i];
        }
        if (wr == 1) PG8_BAR;
    }
    PG8_WAIT_V(0);
    PG8_BAR;
#undef PG8_SA
#undef PG8_SB
#undef PG8_STAGE
#undef PG8_LDA
#undef PG8_LDB
#undef PG8_MMA
#undef PG8_WAIT_V
#undef PG8_WAIT_L
#undef PG8_BAR
#undef PG8_SCHED
#undef PG8_GATHER
}
}

typedef __attribute__((address_space(1))) unsigned gu32;
#define XB_TMO      128
#define XB_XCNT(j)  (256  + 64 * (j))
#define XB_XSUB(j)  (1280 + 64 * (j))
#define XB_XGEN(j)  (2304 + 64 * (j))
#define XB_TOP      3328
#define XB_TOPGEN   3392
#define XCD_BAR_WORDS 3456
#define XB_SPIN_CAP (1u << 18)
__device__ __forceinline__ unsigned xb_ld(unsigned* p)              { return __hip_atomic_load(p, __ATOMIC_RELAXED, __HIP_MEMORY_SCOPE_AGENT); }
__device__ __forceinline__ unsigned xb_add(unsigned* p, unsigned v) { return __hip_atomic_fetch_add(p, v, __ATOMIC_RELAXED, __HIP_MEMORY_SCOPE_AGENT); }
__device__ __forceinline__ unsigned xb_xcc_id() { return (unsigned)__builtin_amdgcn_s_getreg((3 << 11) | 20) & 0xFu; }
#define XB_SPIN(cond, bar) do { unsigned _sp = 0; while (cond) { __builtin_amdgcn_s_sleep(1); \
    if ((++_sp & 255u) == 0u) { if (xb_ld(&(bar)[XB_TMO])) break; if (_sp > XB_SPIN_CAP) { atomicAdd(&(bar)[XB_TMO], 1u); break; } } } } while (0)
struct XcdBarrier { unsigned* bar; unsigned x; volatile LAS unsigned* st; };
__device__ __forceinline__ XcdBarrier xcd_barrier_post(unsigned* bar, volatile LAS unsigned* st) {
    XcdBarrier b; b.bar = bar; b.x = xb_xcc_id(); b.st = st;
    if (threadIdx.x == 0) (void)xb_add(&bar[XB_XCNT(b.x)], 1u);
    return b;
}
__device__ __forceinline__ void xcd_barrier_complete(unsigned* bar, unsigned x, unsigned& nloc, unsigned& nx) {
    const unsigned G = gridDim.x * gridDim.y * gridDim.z;
    unsigned sum, cnt, mine, sp = 0u;
    for (;;) {
        sum = 0u; cnt = 0u; mine = 0u;
#pragma unroll
        for (unsigned j = 0; j < 16; ++j) { const unsigned c = xb_ld(&bar[XB_XCNT(j)]); sum += c; cnt += (c > 0u) ? 1u : 0u; mine = (j == x) ? c : mine; }
        if (sum == G) break;
        __builtin_amdgcn_s_sleep(1);
        if ((++sp & 255u) == 0u) { if (xb_ld(&bar[XB_TMO])) break; if (sp > XB_SPIN_CAP) { atomicAdd(&bar[XB_TMO], 1u); break; } }
    }
    nloc = mine > 0u ? mine : 1u; nx = cnt > 0u ? cnt : 1u;
}
__device__ __forceinline__ void xcd_barrier(const XcdBarrier& b) {
    asm volatile("s_waitcnt vmcnt(0)" ::: "memory");
    __syncthreads();
    if (threadIdx.x == 0) {
        unsigned* bar = b.bar;
        __builtin_amdgcn_s_waitcnt(0);
        unsigned nloc = b.st[0], nx = b.st[1];
        if (nloc == 0u) { xcd_barrier_complete(bar, b.x, nloc, nx); b.st[0] = nloc; b.st[1] = nx; }
        const unsigned old = xb_add(&bar[XB_XSUB(b.x)], 1u);
        const unsigned gen = old / nloc;
        if (old + 1u == (gen + 1u) * nloc) {
            __builtin_amdgcn_fence(__ATOMIC_RELEASE, "agent");
            asm volatile("s_waitcnt vmcnt(0)" ::: "memory");
            const unsigned og = xb_add(&bar[XB_TOP], 1u);
            const unsigned tg = og / nx;
            if (og + 1u == (tg + 1u) * nx) xb_add(&bar[XB_TOPGEN], 1u);
            else XB_SPIN(xb_ld(&bar[XB_TOPGEN]) == tg, bar);
            __builtin_amdgcn_fence(__ATOMIC_ACQUIRE, "agent");
            xb_add(&bar[XB_XGEN(b.x)], 1u);
            asm volatile("s_waitcnt vmcnt(0)" ::: "memory");
        } else {
            XB_SPIN(xb_ld(&bar[XB_XGEN(b.x)]) == gen, bar);
            __builtin_amdgcn_fence(__ATOMIC_ACQUIRE, "agent");
            asm volatile("s_waitcnt vmcnt(0)" ::: "memory");
        }
    }
    __syncthreads();
}

struct Args { const float* in[21]; float* out; unsigned char* ws; int ph_lo, ph_hi; };
struct Frame {
    LAS unsigned char* lds; int tid, lane, wave, G, blk;
    const float *x, *norm1_g, *w_in, *conv_qk, *b_igate, *b_fgate, *g_mlstm_out, *g_gmlp_v, *w_spatial, *b_spatial, *g_gmlp_out, *w_out, *norm2_g,
        *w_rg, *b_rg, *w_re, *b_re, *w_gate, *w_up, *w_down, *final_g;
    float* out; unsigned char* ws;
};

__device__ __forceinline__ void transpose_item(const float* W, int ldw, int col0, int k0, bf16_t* dst, int K, const float* kscale, LAS float* scr, int lane) {
#pragma unroll 8
    for (int i = 0; i < 32; ++i) { const int kk = 2 * i + (lane >> 5); float v = W[(size_t)(k0 + kk) * ldw + col0 + (lane & 31)]; if (kscale) v *= kscale[k0 + kk]; scr[kk * 33 + (lane & 31)] = v; }
    LDS_WAIT(); asm volatile("" ::: "memory");
    const int c = lane & 7;
#pragma unroll
    for (int j = 0; j < 4; ++j) { const int n = (lane >> 3) + 8 * j; const LAS float* s = scr + (8 * c) * 33 + n;
        u32x4 o; o.x = cvt_pk_bf16(s[0 * 33], s[1 * 33]); o.y = cvt_pk_bf16(s[2 * 33], s[3 * 33]); o.z = cvt_pk_bf16(s[4 * 33], s[5 * 33]); o.w = cvt_pk_bf16(s[6 * 33], s[7 * 33]);
        *(u32x4*)(dst + (size_t)n * K + k0 + 8 * c) = o; }
    LDS_WAIT(); asm volatile("" ::: "memory");
}
__device__ __forceinline__ void p0_prologue(Frame& F) {
    LAS float* scr = (LAS float*)(F.lds + F.wave * 16384);
    const int gw = F.blk * NWAVES + F.wave, NGW = F.G * NWAVES;
    bf16_t* WIN = (bf16_t*)(F.ws + WS_WIN); bf16_t* WOUT = (bf16_t*)(F.ws + WS_WOUT); bf16_t* WGU = (bf16_t*)(F.ws + WS_WGU); bf16_t* WD = (bf16_t*)(F.ws + WS_WD);
    constexpr int I_IN = 16 * 96, I_OUT = 16 * 32, I_E = 768, NITEMS = I_IN + I_OUT + NE * I_E;
    for (int it = gw; it < NITEMS; it += NGW) {
        int r = it;
        if (r < I_IN) { const int kb = r / 96, nb = r % 96, n0 = 32 * nb; transpose_item(F.w_in, DIN, n0 < 2048 ? n0 : n0 + 8, 64 * kb, WIN + (size_t)n0 * D, D, nullptr, scr, F.lane); continue; }
        r -= I_IN;
        if (r < I_OUT) { const int kb = r / 32, nb = r % 32; transpose_item(F.w_out, D, 32 * nb, 64 * kb, WOUT + (size_t)(32 * nb) * D, D, nullptr, scr, F.lane); continue; }
        r -= I_OUT;
        const int e = r / I_E; r -= e * I_E;
        if (r < 512) { const bool up = r >= 256; r &= 255; const int kb = r / 16, nb = r % 16, j0 = 32 * nb;
            const float* W = (up ? F.w_up : F.w_gate) + (size_t)e * D * DFF;
            transpose_item(W, DFF, j0, 64 * kb, WGU + ((size_t)e * 1024 + 256 * (j0 >> 7) + (up ? 128 : 0) + (j0 & 127)) * D, D, F.norm2_g, scr, F.lane); continue; }
        r -= 512;
        { const int kb = r / 32, nb = r % 32; transpose_item(F.w_down + (size_t)e * DFF * D, D, 32 * nb, 64 * kb, WD + ((size_t)e * 1024 + 32 * nb) * DFF, DFF, nullptr, scr, F.lane); }
    }
    { const int gt = F.blk * 512 + F.tid, NT_ = F.G * 512; bf16_t* WR = (bf16_t*)(F.ws + WS_WR); bf16_t* WSP = (bf16_t*)(F.ws + WS_WSP);
        for (int i = gt; i < 48 * 1024; i += NT_) { const int n = i >> 10, k = i & 1023; float v = 0.f;
            if (n < 4) v = F.w_rg[k * 4 + n] * F.norm2_g[k]; else if (n < 36) v = F.w_re[k * 32 + (n - 4)] * F.norm2_g[k];
            WR[i] = (bf16_t)f2bf(v); }
        for (int i = gt; i < 8 * 128 * 128; i += NT_) { const int tt = (i >> 7) & 127, s = i & 127; WSP[i] = (bf16_t)f2bf(s <= tt ? F.w_spatial[i] : 0.f); } }
    {
        float wif[4][4][8];
#pragma unroll
        for (int j = 0; j < 4; ++j)
#pragma unroll
            for (int e = 0; e < 4; ++e) { const float* p = F.w_in + (size_t)(256 * j + 4 * F.lane + e) * DIN + 2048; const f32x4 a = *(const f32x4*)p, b = *(const f32x4*)(p + 4);
                wif[j][e][0] = a[0]; wif[j][e][1] = a[1]; wif[j][e][2] = a[2]; wif[j][e][3] = a[3]; wif[j][e][4] = b[0]; wif[j][e][5] = b[1]; wif[j][e][6] = b[2]; wif[j][e][7] = b[3]; }
        f32x4 g1[4];
#pragma unroll
        for (int j = 0; j < 4; ++j) g1[j] = *(const f32x4*)(F.norm1_g + 256 * j + 4 * F.lane);
        bf16_t* XN = (bf16_t*)(F.ws + WS_XN); float* IFP = (float*)(F.ws + WS_IFP);
        for (int m = gw; m < T; m += NGW) {
            const f32x4* xr = (const f32x4*)(F.x + (size_t)m * D) + F.lane;
            f32x4 v[4]; float s = 0.f;
#pragma unroll
            for (int j = 0; j < 4; ++j) { v[j] = xr[64 * j]; s += (v[j][0] * v[j][0] + v[j][1] * v[j][1]) + (v[j][2] * v[j][2] + v[j][3] * v[j][3]); }
            const float rstd = 1.0f / sqrtf(wave_sum(s) * (1.0f / D) + EPS);
            float dot[8];
#pragma unroll
            for (int n = 0; n < 8; ++n) dot[n] = 0.f;
            unsigned long long* o8 = (unsigned long long*)(XN + (size_t)m * D) + F.lane;
#pragma unroll
            for (int j = 0; j < 4; ++j) { v[j] = v[j] * rstd * g1[j];
#pragma unroll
                for (int e = 0; e < 4; ++e)
#pragma unroll
                    for (int n = 0; n < 8; ++n) dot[n] += v[j][e] * wif[j][e][n];
                o8[64 * j] = (unsigned long long)cvt_pk_bf16(v[j][0], v[j][1]) | ((unsigned long long)cvt_pk_bf16(v[j][2], v[j][3]) << 32); }
#pragma unroll
            for (int n = 0; n < 8; ++n) dot[n] = wave_sum(dot[n]);
            if (F.lane < 8) { float val = 0.f;
#pragma unroll
                for (int n = 0; n < 8; ++n) if (F.lane == n) val = dot[n];
                if (F.lane < 4) val += F.b_igate[F.lane];
                else { const float f = val + F.b_fgate[F.lane - 4]; val = (f >= 0.f) ? -log1pf(expf(-f)) : (f - log1pf(expf(f))); }
                IFP[(size_t)m * 8 + F.lane] = val; }
        }
    }
}

__device__ __forceinline__ void conv2rows(const bf16_t* PROJ, const float* conv_w, int trow0, int seqpos0, int r0, int col, float scale, float (&o0)[8], float (&o1)[8]) {
    float xr[5][8];
#pragma unroll
    for (int i = 0; i < 5; ++i) { const int r = r0 - 3 + i;
        if (seqpos0 + r >= 0) { const u32x4 raw = *(const u32x4*)(PROJ + (size_t)(trow0 + r) * NPROJ + col); unpack8(raw, xr[i]); }
        else {
#pragma unroll
            for (int j = 0; j < 8; ++j) xr[i][j] = 0.f;
        } }
    float cw[4][8];
#pragma unroll
    for (int i = 0; i < 4; ++i) { const f32x4 a = *(const f32x4*)(conv_w + i * 1024 + col), b = *(const f32x4*)(conv_w + i * 1024 + col + 4);
        cw[i][0] = a[0]; cw[i][1] = a[1]; cw[i][2] = a[2]; cw[i][3] = a[3]; cw[i][4] = b[0]; cw[i][5] = b[1]; cw[i][6] = b[2]; cw[i][7] = b[3]; }
#pragma unroll
    for (int j = 0; j < 8; ++j) {
        const float y0 = cw[0][j] * xr[0][j] + cw[1][j] * xr[1][j] + cw[2][j] * xr[2][j] + cw[3][j] * xr[3][j];
        const float y1 = cw[0][j] * xr[1][j] + cw[1][j] * xr[2][j] + cw[2][j] * xr[3][j] + cw[3][j] * xr[4][j];
        o0[j] = silu_f(y0) * scale; o1[j] = silu_f(y1) * scale; }
}

constexpr int TS64 = 144;
constexpr int TS128 = 272;
__device__ __forceinline__ void mlstm_local_tile(Frame& F, int bh, int c) {
    const bf16_t* PROJ = (const bf16_t*)(F.ws + WS_PROJ); const float* IFP = (const float*)(F.ws + WS_IFP);
    bf16_t* CST = (bf16_t*)(F.ws + WS_CST); float* NST = (float*)(F.ws + WS_NST); float* CHSC = (float*)(F.ws + WS_CHSC);
    LAS unsigned char* KT = F.lds; LAS unsigned char* VWT = F.lds + 18432; LAS float* WSV = (LAS float*)(F.lds + 36864);
    const int b = bh >> 2, h = bh & 3, trow0 = b * SEQ + c * 64, tid = F.tid, lane = F.lane;
    __syncthreads();
    if (F.wave == 0) {
        const int t = trow0 + lane;
        const float ig = IFP[(size_t)t * 8 + h], lf = IFP[(size_t)t * 8 + 4 + h];
        float bc = lf;
#pragma unroll
        for (int o = 1; o < 64; o <<= 1) { const float v = __shfl_up(bc, o); if (lane >= o) bc += v; }
        const float blast = __shfl(bc, 63);
        const float wst = blast - bc + ig;
        const float mloc = wave_max(wst);
        WSV[lane] = __expf(wst - mloc);
        if (lane == 0) { CHSC[(bh * 128 + c) * 2] = blast; CHSC[(bh * 128 + c) * 2 + 1] = mloc; }
    }
    const int ch = tid & 15, g = tid >> 4;
    {
        float k0[8], k1[8];
        conv2rows(PROJ, F.conv_qk, trow0, c * 64, 2 * g, 512 + h * 128 + 8 * ch, 0.08838834764831845f, k0, k1);
#pragma unroll
        for (int j = 0; j < 8; ++j) *(LAS unsigned*)(KT + (8 * ch + j) * TS64 + 4 * g) = cvt_pk_bf16(k0[j], k1[j]);
    }
    __syncthreads();
    {
        const int col = 1024 + h * 128 + 8 * ch;
        float v0[8], v1[8];
        unpack8(*(const u32x4*)(PROJ + (size_t)(trow0 + 2 * g) * NPROJ + col), v0); unpack8(*(const u32x4*)(PROJ + (size_t)(trow0 + 2 * g + 1) * NPROJ + col), v1);
        const float w0 = WSV[2 * g], w1 = WSV[2 * g + 1];
#pragma unroll
        for (int j = 0; j < 8; ++j) *(LAS unsigned*)(VWT + (8 * ch + j) * TS64 + 4 * g) = cvt_pk_bf16(v0[j] * w0, v1[j] * w1);
    }
    __syncthreads();
    {
        const int fr = lane & 15, fq = lane >> 4, w = F.wave;
        bf16x8 yv[2];
#pragma unroll
        for (int kk = 0; kk < 2; ++kk) yv[kk] = *(const LAS bf16x8*)(VWT + (16 * w + fr) * TS64 + (32 * kk + 8 * fq) * 2);
        bf16_t* dst = CST + ((size_t)(bh * 128 + c) * 128 + 16 * w + fr) * 128;
#pragma unroll
        for (int dt = 0; dt < 8; ++dt) { f32x4 acc = (f32x4){0.f, 0.f, 0.f, 0.f};
#pragma unroll
            for (int kk = 0; kk < 2; ++kk) { const bf16x8 xk = *(const LAS bf16x8*)(KT + (16 * dt + fr) * TS64 + (32 * kk + 8 * fq) * 2); acc = MFMA16(xk, yv[kk], acc); }
            u32x2 o; o.x = cvt_pk_bf16(acc[0], acc[1]); o.y = cvt_pk_bf16(acc[2], acc[3]);
            *(u32x2*)(dst + 16 * dt + 4 * fq) = o; }
    }
    if (tid < 128) { float s = 0.f;
#pragma unroll
        for (int q8 = 0; q8 < 8; ++q8) { float kv[8]; unpack8(*(const LAS u32x4*)(KT + tid * TS64 + q8 * 16), kv);
#pragma unroll
            for (int j = 0; j < 8; ++j) s += kv[j] * WSV[q8 * 8 + j]; }
        NST[(size_t)(bh * 128 + c) * 128 + tid] = s; }
}

__device__ __forceinline__ void gmlp_tile(Frame& F, int tile) {
    const bf16_t* PROJ = (const bf16_t*)(F.ws + WS_PROJ); const bf16_t* WSP = (const bf16_t*)(F.ws + WS_WSP); bf16_t* Y = (bf16_t*)(F.ws + WS_Y);
    LAS unsigned char* VBT = F.lds; LAS unsigned char* WS_ = F.lds + 17408; LAS float* RST = (LAS float*)(F.lds + 52224);
    const int trow0 = tile * 128, tid = F.tid, lane = F.lane, w = F.wave, fr = lane & 15, fq = lane >> 4;
    __syncthreads();
    for (int r = 0; r < 16; ++r) { const int row = w * 16 + r; float v[8]; unpack8(*(const u32x4*)(PROJ + (size_t)(trow0 + row) * NPROJ + 2560 + 8 * lane), v);
        float s = 0.f;
#pragma unroll
        for (int j = 0; j < 8; ++j) s += v[j] * v[j];
        s = wave_sum(s); if (lane == 0) RST[row] = 1.0f / sqrtf(s * (1.0f / 512.0f) + EPS); }
    for (int g = 0; g < 8; ++g) {
        __syncthreads();
        {
            const int ch = tid & 7, rp = tid >> 3, col = 2560 + 64 * g + 8 * ch;
            float v0[8], v1[8];
            unpack8(*(const u32x4*)(PROJ + (size_t)(trow0 + 2 * rp) * NPROJ + col), v0); unpack8(*(const u32x4*)(PROJ + (size_t)(trow0 + 2 * rp + 1) * NPROJ + col), v1);
            const float r0 = RST[2 * rp], r1 = RST[2 * rp + 1];
            const f32x4 ga = *(const f32x4*)(F.g_gmlp_v + 64 * g + 8 * ch), gb = *(const f32x4*)(F.g_gmlp_v + 64 * g + 8 * ch + 4);
            const float gg[8] = {ga[0], ga[1], ga[2], ga[3], gb[0], gb[1], gb[2], gb[3]};
#pragma unroll
            for (int j = 0; j < 8; ++j) *(LAS unsigned*)(VBT + (8 * ch + j) * TS128 + 4 * rp) = cvt_pk_bf16(v0[j] * r0 * gg[j], v1[j] * r1 * gg[j]);
        }
#pragma unroll
        for (int i = 0; i < 4; ++i) { const int id = tid + 512 * i, row = id >> 4, c16 = id & 15;
            *(LAS u32x4*)(WS_ + row * TS128 + c16 * 16) = *(const u32x4*)(WSP + (size_t)(g * 128 + row) * 128 + c16 * 8); }
        __syncthreads();
        f32x4 acc[4];
#pragma unroll
        for (int ct = 0; ct < 4; ++ct) acc[ct] = (f32x4){0.f, 0.f, 0.f, 0.f};
#pragma unroll
        for (int kk = 0; kk < 4; ++kk) { const bf16x8 yw = *(const LAS bf16x8*)(WS_ + (16 * w + fr) * TS128 + (32 * kk + 8 * fq) * 2);
#pragma unroll
            for (int ct = 0; ct < 4; ++ct) { const bf16x8 xv = *(const LAS bf16x8*)(VBT + (16 * ct + fr) * TS128 + (32 * kk + 8 * fq) * 2); acc[ct] = MFMA16(xv, yw, acc[ct]); } }
        const int tt = 16 * w + fr, trow = trow0 + tt;
        const float bias = F.b_spatial[g * 128 + tt];
        float gv[4][4]; float ss = 0.f;
#pragma unroll
        for (int ct = 0; ct < 4; ++ct) { const u32x2 ur = *(const u32x2*)(PROJ + (size_t)trow * NPROJ + 2048 + 64 * g + 16 * ct + 4 * fq);
            const float uu[4] = {bflo(ur.x), bfhi(ur.x), bflo(ur.y), bfhi(ur.y)};
#pragma unroll
            for (int j = 0; j < 4; ++j) { gv[ct][j] = uu[j] * (acc[ct][j] + bias); ss += gv[ct][j] * gv[ct][j]; } }
        ss += __shfl_xor(ss, 16); ss += __shfl_xor(ss, 32);
        const float rs = 1.0f / sqrtf(ss * (1.0f / 64.0f) + EPS);
#pragma unroll
        for (int ct = 0; ct < 4; ++ct) { const f32x4 go = *(const f32x4*)(F.g_gmlp_out + 64 * g + 16 * ct + 4 * fq);
            u32x2 o; o.x = cvt_pk_bf16(gv[ct][0] * rs * go[0], gv[ct][1] * rs * go[1]); o.y = cvt_pk_bf16(gv[ct][2] * rs * go[2], gv[ct][3] * rs * go[3]);
            *(u32x2*)(Y + (size_t)trow * D + 512 + 64 * g + 16 * ct + 4 * fq) = o; }
    }
}

__device__ __forceinline__ void scan_phase(Frame& F) {
    const float* CHSC = (const float*)(F.ws + WS_CHSC); float* MST = (float*)(F.ws + WS_MST); float* NST = (float*)(F.ws + WS_NST);
    unsigned* CST = (unsigned*)(F.ws + WS_CST);
    LAS float* SA = (LAS float*)F.lds; LAS float* SB = SA + 128; LAS float* SCB = SB + 128;
    const int bh = F.blk >> 4, sub = F.blk & 15, tid = F.tid;
    __syncthreads();
    if (tid < 256) SCB[tid] = CHSC[bh * 256 + tid];
    __syncthreads();
    if (tid == 0) { float m = 0.f;
        for (int c = 0; c < 128; ++c) { const float blast = SCB[2 * c], mloc = SCB[2 * c + 1]; const float mn = fmaxf(blast + m, mloc);
            SA[c] = __expf(blast + m - mn); SB[c] = __expf(mloc - mn); if (sub == 0) MST[bh * 128 + c] = m; m = mn; } }
    __syncthreads();
    if (F.G == 256) {
        unsigned* p = CST + (size_t)bh * 128 * 8192 + sub * 512 + tid;
        float s0 = 0.f, s1 = 0.f;
        for (int c0 = 0; c0 < 128; c0 += 8) { unsigned kl[8];
#pragma unroll
            for (int i = 0; i < 8; ++i) kl[i] = p[(size_t)(c0 + i) * 8192];
#pragma unroll
            for (int i = 0; i < 8; ++i) { p[(size_t)(c0 + i) * 8192] = cvt_pk_bf16(s0, s1); const float a = SA[c0 + i], b = SB[c0 + i]; s0 = a * s0 + b * bflo(kl[i]); s1 = a * s1 + b * bfhi(kl[i]); } }
        if (sub == 0 && tid < 128) { float s = 0.f; float* q = NST + (size_t)bh * 128 * 128 + tid;
            for (int c = 0; c < 128; ++c) { const float nl = q[c * 128]; q[c * 128] = s; s = SA[c] * s + SB[c] * nl; } }
    }
}

__device__ __forceinline__ void mlstm_out_tile(Frame& F, int bh, int c) {
    const bf16_t* PROJ = (const bf16_t*)(F.ws + WS_PROJ); const float* IFP = (const float*)(F.ws + WS_IFP);
    const bf16_t* CST = (const bf16_t*)(F.ws + WS_CST); const float* NST = (const float*)(F.ws + WS_NST); const float* MST = (const float*)(F.ws + WS_MST);
    bf16_t* Y = (bf16_t*)(F.ws + WS_Y);
    LAS unsigned char* Q = F.lds; LAS unsigned char* QW = F.lds + 17408; LAS unsigned char* KK = F.lds + 34816; LAS unsigned char* VT = F.lds + 52224;
    LAS unsigned char* CS = F.lds + 72960; LAS unsigned char* P = F.lds + 112128; LAS float* SC = (LAS float*)(F.lds + 121344); LAS float* HBUF = (LAS float*)F.lds;
    LAS float* S_BC = SC, * S_A = SC + 64, * S_MT = SC + 128, * S_WI = SC + 192, * S_EN = SC + 256, * S_NQ = SC + 320;
    const int b = bh >> 2, h = bh & 3, trow0 = b * SEQ + c * 64, tid = F.tid, lane = F.lane, w = F.wave, fr = lane & 15, fq = lane >> 4;
    __syncthreads();
    if (w == 0) {
        const int t = trow0 + lane; const float mc = MST[bh * 128 + c];
        const float ig = IFP[(size_t)t * 8 + h], lf = IFP[(size_t)t * 8 + 4 + h];
        float bc = lf;
#pragma unroll
        for (int o = 1; o < 64; o <<= 1) { const float v = __shfl_up(bc, o); if (lane >= o) bc += v; }
        const float a = ig - bc; float pm = a;
#pragma unroll
        for (int o = 1; o < 64; o <<= 1) { const float v = __shfl_up(pm, o); if (lane >= o) pm = fmaxf(pm, v); }
        const float inter = bc + mc, mt = fmaxf(inter, bc + pm);
        S_BC[lane] = bc; S_A[lane] = a; S_MT[lane] = mt; S_WI[lane] = __expf(inter - mt); S_EN[lane] = __expf(-mt);
    }
    const int ch = tid & 15, g = tid >> 4;
    float q0[8], q1[8];
    conv2rows(PROJ, F.conv_qk, trow0, c * 64, 2 * g, h * 128 + 8 * ch, 1.0f, q0, q1);
    {
        float k0[8], k1[8];
        conv2rows(PROJ, F.conv_qk, trow0, c * 64, 2 * g, 512 + h * 128 + 8 * ch, 0.08838834764831845f, k0, k1);
        u32x4 o; o.x = cvt_pk_bf16(k0[0], k0[1]); o.y = cvt_pk_bf16(k0[2], k0[3]); o.z = cvt_pk_bf16(k0[4], k0[5]); o.w = cvt_pk_bf16(k0[6], k0[7]);
        *(LAS u32x4*)(KK + (2 * g) * TS128 + 16 * ch) = o;
        o.x = cvt_pk_bf16(k1[0], k1[1]); o.y = cvt_pk_bf16(k1[2], k1[3]); o.z = cvt_pk_bf16(k1[4], k1[5]); o.w = cvt_pk_bf16(k1[6], k1[7]);
        *(LAS u32x4*)(KK + (2 * g + 1) * TS128 + 16 * ch) = o;
        o.x = cvt_pk_bf16(q0[0], q0[1]); o.y = cvt_pk_bf16(q0[2], q0[3]); o.z = cvt_pk_bf16(q0[4], q0[5]); o.w = cvt_pk_bf16(q0[6], q0[7]);
        *(LAS u32x4*)(Q + (2 * g) * TS128 + 16 * ch) = o;
        o.x = cvt_pk_bf16(q1[0], q1[1]); o.y = cvt_pk_bf16(q1[2], q1[3]); o.z = cvt_pk_bf16(q1[4], q1[5]); o.w = cvt_pk_bf16(q1[6], q1[7]);
        *(LAS u32x4*)(Q + (2 * g + 1) * TS128 + 16 * ch) = o;
    }
    {
        const int col = 1024 + h * 128 + 8 * ch; float v0[8], v1[8];
        unpack8(*(const u32x4*)(PROJ + (size_t)(trow0 + 2 * g) * NPROJ + col), v0); unpack8(*(const u32x4*)(PROJ + (size_t)(trow0 + 2 * g + 1) * NPROJ + col), v1);
#pragma unroll
        for (int j = 0; j < 8; ++j) *(LAS unsigned*)(VT + (8 * ch + j) * TS64 + 4 * g) = cvt_pk_bf16(v0[j], v1[j]);
        *(LAS unsigned*)(VT + (128 + (tid >> 5)) * TS64 + 4 * (tid & 31)) = (tid < 32) ? 0x3F803F80u : 0u;
    }
    {
        const bf16_t* src = CST + (size_t)(bh * 128 + c) * 16384;
#pragma unroll
        for (int i = 0; i < 4; ++i) { const int id = tid + 512 * i, row = id >> 4, c16 = id & 15; *(LAS u32x4*)(CS + row * TS128 + c16 * 16) = *(const u32x4*)(src + row * 128 + c16 * 8); }
        if (tid < 64) { const float* ns = NST + (size_t)(bh * 128 + c) * 128 + 2 * tid; *(LAS unsigned*)(CS + 128 * TS128 + 4 * tid) = cvt_pk_bf16(ns[0], ns[1]); }
        else if (tid < 64 + 240) { const int id = tid - 64, row = 129 + (id >> 4), c16 = id & 15; *(LAS u32x4*)(CS + row * TS128 + c16 * 16) = (u32x4){0u, 0u, 0u, 0u}; }
    }
    __syncthreads();
    {
        const float w0 = S_WI[2 * g], w1 = S_WI[2 * g + 1];
        u32x4 o; o.x = cvt_pk_bf16(q0[0] * w0, q0[1] * w0); o.y = cvt_pk_bf16(q0[2] * w0, q0[3] * w0); o.z = cvt_pk_bf16(q0[4] * w0, q0[5] * w0); o.w = cvt_pk_bf16(q0[6] * w0, q0[7] * w0);
        *(LAS u32x4*)(QW + (2 * g) * TS128 + 16 * ch) = o;
        o.x = cvt_pk_bf16(q1[0] * w1, q1[1] * w1); o.y = cvt_pk_bf16(q1[2] * w1, q1[3] * w1); o.z = cvt_pk_bf16(q1[4] * w1, q1[5] * w1); o.w = cvt_pk_bf16(q1[6] * w1, q1[7] * w1);
        *(LAS u32x4*)(QW + (2 * g + 1) * TS128 + 16 * ch) = o;
    }
    {
        const int lt = w >> 1; const int l = 16 * lt + fr; const float bl = S_BC[l], ml = S_MT[l];
#pragma unroll
        for (int si = 0; si < 2; ++si) { const int st = 2 * (w & 1) + si; f32x4 acc = (f32x4){0.f, 0.f, 0.f, 0.f};
            if (st <= lt) {
#pragma unroll
                for (int kk = 0; kk < 4; ++kk) { const bf16x8 xk = *(const LAS bf16x8*)(KK + (16 * st + fr) * TS128 + (32 * kk + 8 * fq) * 2); const bf16x8 yq = *(const LAS bf16x8*)(Q + l * TS128 + (32 * kk + 8 * fq) * 2); acc = MFMA16(xk, yq, acc); }
            }
            float pv[4];
#pragma unroll
            for (int j = 0; j < 4; ++j) { const int s = 16 * st + 4 * fq + j; pv[j] = (s <= l) ? acc[j] * __expf(bl + S_A[s] - ml) : 0.f; }
            u32x2 o; o.x = cvt_pk_bf16(pv[0], pv[1]); o.y = cvt_pk_bf16(pv[2], pv[3]);
            *(LAS u32x2*)(P + l * TS64 + (16 * st + 4 * fq) * 2) = o; }
    }
    __syncthreads();
    f32x4 acc[4], accx = (f32x4){0.f, 0.f, 0.f, 0.f};
#pragma unroll
    for (int lt = 0; lt < 4; ++lt) { acc[lt] = (f32x4){0.f, 0.f, 0.f, 0.f};
#pragma unroll
        for (int kk = 0; kk < 2; ++kk) { const bf16x8 xv = *(const LAS bf16x8*)(VT + (16 * w + fr) * TS64 + (32 * kk + 8 * fq) * 2); const bf16x8 yp = *(const LAS bf16x8*)(P + (16 * lt + fr) * TS64 + (32 * kk + 8 * fq) * 2); acc[lt] = MFMA16(xv, yp, acc[lt]); }
#pragma unroll
        for (int kk = 0; kk < 4; ++kk) { const bf16x8 xc = *(const LAS bf16x8*)(CS + (16 * w + fr) * TS128 + (32 * kk + 8 * fq) * 2); const bf16x8 yq = *(const LAS bf16x8*)(QW + (16 * lt + fr) * TS128 + (32 * kk + 8 * fq) * 2); acc[lt] = MFMA16(xc, yq, acc[lt]); } }
    if (w < 4) {
#pragma unroll
        for (int kk = 0; kk < 2; ++kk) { const bf16x8 xv = *(const LAS bf16x8*)(VT + (128 + fr) * TS64 + (32 * kk + 8 * fq) * 2); const bf16x8 yp = *(const LAS bf16x8*)(P + (16 * w + fr) * TS64 + (32 * kk + 8 * fq) * 2); accx = MFMA16(xv, yp, accx); }
#pragma unroll
        for (int kk = 0; kk < 4; ++kk) { const bf16x8 xc = *(const LAS bf16x8*)(CS + (128 + fr) * TS128 + (32 * kk + 8 * fq) * 2); const bf16x8 yq = *(const LAS bf16x8*)(QW + (16 * w + fr) * TS128 + (32 * kk + 8 * fq) * 2); accx = MFMA16(xc, yq, accx); }
        if (fq == 0) S_NQ[16 * w + fr] = accx[0];
    }
    __syncthreads();
#pragma unroll
    for (int lt = 0; lt < 4; ++lt) *(LAS f32x4*)(HBUF + (16 * lt + fr) * 132 + 16 * w + 4 * fq) = acc[lt];
    __syncthreads();
    {
        const int l = tid >> 3, seg = tid & 7, t = trow0 + l;
        const float den = 1.0f / fmaxf(fabsf(S_NQ[l]), S_EN[l]);
        float ov[16]; { float t8[8]; unpack8(*(const u32x4*)(PROJ + (size_t)t * NPROJ + 1536 + h * 128 + 16 * seg), t8);
#pragma unroll
            for (int j = 0; j < 8; ++j) ov[j] = t8[j];
            unpack8(*(const u32x4*)(PROJ + (size_t)t * NPROJ + 1536 + h * 128 + 16 * seg + 8), t8);
#pragma unroll
            for (int j = 0; j < 8; ++j) ov[8 + j] = t8[j]; }
        float hv[16]; float ss = 0.f;
#pragma unroll
        for (int j4 = 0; j4 < 4; ++j4) { const f32x4 nv = *(const LAS f32x4*)(HBUF + l * 132 + 16 * seg + 4 * j4);
#pragma unroll
            for (int j = 0; j < 4; ++j) { const float x = nv[j] * den * ov[4 * j4 + j]; hv[4 * j4 + j] = x; ss += x * x; } }
        ss += __shfl_xor(ss, 1); ss += __shfl_xor(ss, 2); ss += __shfl_xor(ss, 4);
        const float rs = 1.0f / sqrtf(ss * (1.0f / 128.0f) + EPS);
        const float* gm = F.g_mlstm_out + h * 128 + 16 * seg;
#pragma unroll
        for (int j = 0; j < 16; ++j) hv[j] *= rs * gm[j];
        u32x4 o; o.x = cvt_pk_bf16(hv[0], hv[1]); o.y = cvt_pk_bf16(hv[2], hv[3]); o.z = cvt_pk_bf16(hv[4], hv[5]); o.w = cvt_pk_bf16(hv[6], hv[7]);
        *(u32x4*)(Y + (size_t)t * D + h * 128 + 16 * seg) = o;
        o.x = cvt_pk_bf16(hv[8], hv[9]); o.y = cvt_pk_bf16(hv[10], hv[11]); o.z = cvt_pk_bf16(hv[12], hv[13]); o.w = cvt_pk_bf16(hv[14], hv[15]);
        *(u32x4*)(Y + (size_t)t * D + h * 128 + 16 * seg + 8) = o;
    }
}

constexpr int WR_STR = 2064;
__device__ __forceinline__ void router_phase(Frame& F) {
    const bf16_t* HB = (const bf16_t*)(F.ws + WS_HB); const bf16_t* WR = (const bf16_t*)(F.ws + WS_WR); const float* HSQ = (const float*)(F.ws + WS_HSQ);
    unsigned* LIST = (unsigned*)(F.ws + WS_LIST); float* SRSTD = (float*)(F.ws + WS_SRSTD); float* SW = (float*)(F.ws + WS_SW); unsigned* GCNT = (unsigned*)(F.ws + WS_CTL) + CW_GCNT;
    LAS unsigned char* WRL = F.lds; LAS float* LOG = (LAS float*)(F.lds + 99072); LAS unsigned* CNT = (LAS unsigned*)(F.lds + 99072 + 26624); LAS unsigned* BASE = CNT + 32;
    const int tid = F.tid, lane = F.lane, w = F.wave, fr = lane & 15, fq = lane >> 4;
    for (int tb = F.blk; tb < T / 128; tb += F.G) {
        __syncthreads();
#pragma unroll
        for (int i = 0; i < 12; ++i) { const int id = tid + 512 * i, row = id >> 7, c16 = id & 127; *(LAS u32x4*)(WRL + row * WR_STR + c16 * 16) = *(const u32x4*)(WR + (size_t)row * 1024 + c16 * 8); }
        if (tid < 32) CNT[tid] = 0u;
        __syncthreads();
        const int t0 = tb * 128 + w * 16;
        f32x4 acc[3];
#pragma unroll
        for (int nt = 0; nt < 3; ++nt) acc[nt] = (f32x4){0.f, 0.f, 0.f, 0.f};
        const bf16_t* hrow = HB + (size_t)(t0 + fr) * D + 8 * fq;
#pragma unroll 8
        for (int kk = 0; kk < 32; ++kk) { const bf16x8 y = *(const bf16x8*)(hrow + 32 * kk);
#pragma unroll
            for (int nt = 0; nt < 3; ++nt) { const bf16x8 x = *(const LAS bf16x8*)(WRL + (16 * nt + fr) * WR_STR + (32 * kk + 8 * fq) * 2); acc[nt] = MFMA16(x, y, acc[nt]); } }
        LAS float* lg = LOG + w * (16 * 52);
#pragma unroll
        for (int nt = 0; nt < 3; ++nt) *(LAS f32x4*)(lg + fr * 52 + 16 * nt + 4 * fq) = acc[nt];
        __syncthreads();
        int e0 = 0, e1 = 0; unsigned r0 = 0, r1 = 0; float w0 = 0.f, w1 = 0.f, rstd = 0.f; const int t = t0 + lane;
        if (lane < 16) {
            float ss = 0.f;
#pragma unroll
            for (int i = 0; i < 4; ++i) { const f32x4 v = *(const f32x4*)(HSQ + (size_t)t * 16 + 4 * i); ss += (v[0] + v[1]) + (v[2] + v[3]); }
            rstd = 1.0f / sqrtf(ss * (1.0f / D) + EPS);
            const LAS float* L = lg + lane * 52;
            float gl[4]; int gs = 0; float gmx;
#pragma unroll
            for (int i = 0; i < 4; ++i) gl[i] = L[i] * rstd + F.b_rg[i];
            gmx = gl[0];
#pragma unroll
            for (int i = 1; i < 4; ++i) if (gl[i] > gmx) { gmx = gl[i]; gs = i; }
            float gsum = 0.f;
#pragma unroll
            for (int i = 0; i < 4; ++i) gsum += __expf(gl[i] - gmx);
            const float pg = 1.0f / gsum;
            float el[8];
#pragma unroll
            for (int i = 0; i < 8; ++i) el[i] = L[4 + gs * 8 + i] * rstd + F.b_re[gs * 8 + i];
            int i0 = 0; float m0 = el[0];
#pragma unroll
            for (int i = 1; i < 8; ++i) if (el[i] > m0) { m0 = el[i]; i0 = i; }
            int i1 = (i0 == 0) ? 1 : 0; float m1 = (i0 == 0) ? el[1] : el[0];
#pragma unroll
            for (int i = 1; i < 8; ++i) if (i != i0 && el[i] > m1) { m1 = el[i]; i1 = i; }
            const float ex = __expf(m1 - m0);
            w0 = pg / (1.0f + ex); w1 = pg * ex / (1.0f + ex);
            e0 = gs * 8 + i0; e1 = gs * 8 + i1;
            r0 = atomicAdd((unsigned*)&CNT[e0], 1u); r1 = atomicAdd((unsigned*)&CNT[e1], 1u);
        }
        __syncthreads();
        if (tid < 32) BASE[tid] = __hip_atomic_fetch_add(GCNT + tid, CNT[tid], __ATOMIC_RELAXED, __HIP_MEMORY_SCOPE_AGENT);
        __syncthreads();
        if (lane < 16) {
            const unsigned i0 = (unsigned)e0 * CAP + BASE[e0] + r0, i1 = (unsigned)e1 * CAP + BASE[e1] + r1;
            LIST[i0] = 2u * t; SRSTD[i0] = rstd; SW[i0] = w0;
            LIST[i1] = 2u * t + 1u; SRSTD[i1] = rstd; SW[i1] = w1;
        }
    }
}

__device__ __forceinline__ void final_phase(Frame& F) {
    const bf16_t* HB = (const bf16_t*)(F.ws + WS_HB); const bf16_t* YE = (const bf16_t*)(F.ws + WS_YE);
    const int gw = F.blk * NWAVES + F.wave, NGW = F.G * NWAVES, lane = F.lane;
    f32x4 fg[4];
#pragma unroll
    for (int i = 0; i < 4; ++i) fg[i] = *(const f32x4*)(F.final_g + 16 * lane + 4 * i);
    for (int m = gw; m < T; m += NGW) {
        float v[16]; float s = 0.f;
#pragma unroll
        for (int hh = 0; hh < 2; ++hh) { float a[8], b[8], c[8];
            unpack8(*(const u32x4*)(HB + (size_t)m * D + 16 * lane + 8 * hh), a);
            unpack8(*(const u32x4*)(YE + (size_t)(2 * m) * D + 16 * lane + 8 * hh), b);
            unpack8(*(const u32x4*)(YE + (size_t)(2 * m + 1) * D + 16 * lane + 8 * hh), c);
#pragma unroll
            for (int j = 0; j < 8; ++j) { float x = a[j]; if (MK_DBG_MOE != 0.0f) x += b[j] + c[j]; if (!(fabsf(x) < 1e30f)) x = 0.f; v[8 * hh + j] = x; s += x * x; } }
        const float rstd = 1.0f / sqrtf(wave_sum(s) * (1.0f / D) + EPS);
        float* o = F.out + (size_t)m * D + 16 * lane;
#pragma unroll
        for (int i = 0; i < 4; ++i) { f32x4 r; r[0] = v[4 * i] * rstd * fg[i][0]; r[1] = v[4 * i + 1] * rstd * fg[i][1]; r[2] = v[4 * i + 2] * rstd * fg[i][2]; r[3] = v[4 * i + 3] * rstd * fg[i][3]; *(f32x4*)(o + 4 * i) = r; }
    }
}


#ifndef MK_DBG_TELE
#define MK_DBG_TELE 0
#endif
constexpr int CW_TELE = 128;
__device__ __forceinline__ void dbg_count_bf16(Frame& F, const bf16_t* p, size_t n, int slot) {
    unsigned bad = 0; const size_t gt = (size_t)F.blk * 512 + F.tid, NT_ = (size_t)F.G * 512;
    for (size_t i = gt; i < n; i += NT_) { const float v = bflo((unsigned)p[i]); if (!(fabsf(v) < 1.0e6f)) ++bad; }
    if (bad) atomicAdd((unsigned*)(F.ws + WS_CTL) + CW_TELE + slot, bad);
}
__device__ __forceinline__ void dbg_count_f32(Frame& F, const float* p, size_t n, int slot) {
    unsigned bad = 0; const size_t gt = (size_t)F.blk * 512 + F.tid, NT_ = (size_t)F.G * 512;
    for (size_t i = gt; i < n; i += NT_) { const float v = p[i]; if (!(fabsf(v) < 1.0e6f)) ++bad; }
    if (bad) atomicAdd((unsigned*)(F.ws + WS_CTL) + CW_TELE + slot, bad);
}
__device__ __forceinline__ void dbg_check_phase(Frame& F, int p) {
    if (p == 0) { dbg_count_bf16(F, (const bf16_t*)(F.ws + WS_XN), (size_t)T * D, 1); dbg_count_f32(F, (const float*)(F.ws + WS_IFP), (size_t)T * 8, 2); dbg_count_bf16(F, (const bf16_t*)(F.ws + WS_WIN), (size_t)NPROJ * D, 3);
                  dbg_count_bf16(F, (const bf16_t*)(F.ws + WS_WGU), (size_t)NE * 1024 * D, 4); dbg_count_bf16(F, (const bf16_t*)(F.ws + WS_WD), (size_t)NE * 1024 * DFF, 5); dbg_count_bf16(F, (const bf16_t*)(F.ws + WS_WOUT), (size_t)D * D, 6); }
    if (p == 1) dbg_count_bf16(F, (const bf16_t*)(F.ws + WS_PROJ), (size_t)T * NPROJ, 7);
    if (p == 2) { dbg_count_bf16(F, (const bf16_t*)(F.ws + WS_CST), (size_t)2048 * 16384, 8); dbg_count_f32(F, (const float*)(F.ws + WS_NST), (size_t)2048 * 128, 9); dbg_count_f32(F, (const float*)(F.ws + WS_CHSC), (size_t)4096, 10); }
    if (p == 3) { dbg_count_bf16(F, (const bf16_t*)(F.ws + WS_CST), (size_t)2048 * 16384, 11); dbg_count_f32(F, (const float*)(F.ws + WS_NST), (size_t)2048 * 128, 12); dbg_count_f32(F, (const float*)(F.ws + WS_MST), (size_t)2048, 13); }
    if (p == 4) dbg_count_bf16(F, (const bf16_t*)(F.ws + WS_Y), (size_t)T * D, 14);
    if (p == 5) { dbg_count_bf16(F, (const bf16_t*)(F.ws + WS_HB), (size_t)T * D, 15); dbg_count_f32(F, (const float*)(F.ws + WS_HSQ), (size_t)T * 16, 16); }
    if (p == 8) dbg_count_bf16(F, (const bf16_t*)(F.ws + WS_YE), (size_t)2 * T * D, 17);
}
__device__ __forceinline__ void dbg_msq(Frame& F, size_t wsoff, int isf32, int rows, int ld, int c0, int nc) {
    float acc = 0.f; const size_t gt = (size_t)F.blk * 512 + F.tid, NT_ = (size_t)F.G * 512, n = (size_t)rows * nc;
    for (size_t i = gt; i < n; i += NT_) { const size_t r = i / nc, c = c0 + i % nc; float v = isf32 ? ((const float*)(F.ws + wsoff))[r * ld + c] : bflo((unsigned)((const bf16_t*)(F.ws + wsoff))[r * ld + c]);
        if (!(fabsf(v) < 1.0e6f)) v = 1.0e6f; acc += v * v; }
    acc = wave_sum(acc);
    if (F.lane == 0) atomicAdd((float*)(F.ws + WS_CTL) + CW_TELE + 40, acc / (float)n);
}
__device__ __forceinline__ void dbg_msq_phase(Frame& F, int p) {
    const int m = MK_DBG_TELE - 100;
    if (p == 0 && m == 0) dbg_msq(F, WS_XN, 0, T, D, 0, D);
    if (p == 0 && m == 1) dbg_msq(F, WS_WIN, 0, NPROJ, D, 0, D);
    if (p == 0 && m == 2) dbg_msq(F, WS_IFP, 1, T, 8, 0, 8);
    if (p == 1 && m == 3) dbg_msq(F, WS_PROJ, 0, T, NPROJ, 0, 1024);
    if (p == 1 && m == 4) dbg_msq(F, WS_PROJ, 0, T, NPROJ, 1024, 512);
    if (p == 1 && m == 5) dbg_msq(F, WS_PROJ, 0, T, NPROJ, 1536, 512);
    if (p == 1 && m == 6) dbg_msq(F, WS_PROJ, 0, T, NPROJ, 2048, 1024);
    if (p == 2 && m == 7) dbg_msq(F, WS_CST, 0, 2048 * 128, 128, 0, 128);
    if (p == 2 && m == 8) dbg_msq(F, WS_Y, 0, T, D, 512, 512);
    if (p == 3 && m == 9) dbg_msq(F, WS_CST, 0, 2048 * 128, 128, 0, 128);
    if (p == 4 && m == 10) dbg_msq(F, WS_Y, 0, T, D, 0, 512);
    if (p == 5 && m == 11) dbg_msq(F, WS_HB, 0, T, D, 0, D);
    if (p == 8 && m == 12) dbg_msq(F, WS_YE, 0, 2 * T, D, 0, D);
    if (p == 2 && m == 13) dbg_msq(F, WS_NST, 1, 2048, 128, 0, 128);
    if (p == 2 && m == 14) dbg_msq(F, WS_CHSC, 1, 2048, 2, 0, 2);
}
__device__ __forceinline__ void dbg_tele_out(Frame& F) {
    const unsigned* tc = (const unsigned*)(F.ws + WS_CTL) + CW_TELE; float val = 0.5f;
    if (MK_DBG_TELE == 1) { for (int sl = 1; sl < 32; ++sl) { const unsigned c = tc[sl]; if (c) { val = 100.0f * sl + (float)(31 - __builtin_clz(c)); break; } } }
    else if (MK_DBG_TELE >= 100) { val = 1000.0f * ((const float*)tc)[40]; }
    else { val = (float)tc[MK_DBG_TELE]; }
    const size_t gt = (size_t)F.blk * 512 + F.tid, NT_ = (size_t)F.G * 512;
    for (size_t i = gt; i < (size_t)T * D; i += NT_) F.out[i] = val;
}
constexpr int NPHASES = 10;
#ifndef MK_DBG_NPH
#define MK_DBG_NPH 10
#endif
__global__ void __launch_bounds__(NWAVES * 64, 2) mk_fwd(Args args) {
    extern __shared__ __attribute__((aligned(16))) unsigned char lds_raw[];
    Frame F;
    F.lds = (LAS unsigned char*)lds_raw;
    F.tid = threadIdx.x; F.lane = F.tid & 63; F.wave = __builtin_amdgcn_readfirstlane(F.tid >> 6); F.G = gridDim.x; F.blk = blockIdx.x;
    F.x = args.in[0]; F.norm1_g = args.in[1]; F.w_in = args.in[2]; F.conv_qk = args.in[3]; F.b_igate = args.in[4]; F.b_fgate = args.in[5]; F.g_mlstm_out = args.in[6];
    F.g_gmlp_v = args.in[7]; F.w_spatial = args.in[8]; F.b_spatial = args.in[9]; F.g_gmlp_out = args.in[10]; F.w_out = args.in[11]; F.norm2_g = args.in[12];
    F.w_rg = args.in[13]; F.b_rg = args.in[14]; F.w_re = args.in[15]; F.b_re = args.in[16]; F.w_gate = args.in[17]; F.w_up = args.in[18]; F.w_down = args.in[19]; F.final_g = args.in[20];
    F.out = args.out; F.ws = args.ws;
    volatile LAS unsigned* MISC = (volatile LAS unsigned*)(F.lds + MISC_OFF);
    for (int u = F.tid; u < (LDS_BYTES - TBL_OFF) / 4; u += NWAVES * 64) ((LAS unsigned*)(F.lds + TBL_OFF))[u] = 0u;
    __syncthreads();
    unsigned* ctl = (unsigned*)(F.ws + WS_CTL);
    XcdBarrier bar; bar.bar = ctl + CW_BAR; bar.x = 0; bar.st = nullptr;
    if (MK_N_LAUNCHES == 1) bar = xcd_barrier_post(ctl + CW_BAR, MISC + 8);
    const int lo = args.ph_lo, hi = args.ph_hi;
#define IN(k) (lo <= (k) && (k) < hi)
#define SEAM(k) do { if (IN(k) && IN((k) + 1)) xcd_barrier(bar); } while (0)

    if (IN(0)) { p0_prologue(F); } SEAM(0);
    if (IN(1)) {
        pg8::Gemm g{(const bf16_t*)(F.ws + WS_XN), (const bf16_t*)(F.ws + WS_WIN), T, NPROJ, D, nullptr}; pg8::StaticOrder S; S.init(T, NPROJ, F.G, F.blk);
        pg8::EpiP1 E{(bf16_t*)(F.ws + WS_PROJ)};
        pg8::gemm_phase<pg8::EpiP1, pg8::StaticOrder, false>(F.lds, g, S, E);
    } SEAM(1);
    if (IN(2)) {
        for (int it = F.blk; it < 2048 + 256; it += F.G) { if (it < 2048) mlstm_local_tile(F, it >> 7, it & 127); else gmlp_tile(F, it - 2048); }
    } SEAM(2);
    if (IN(3)) { scan_phase(F); } SEAM(3);
    if (IN(4)) { for (int it = F.blk; it < 2048; it += F.G) mlstm_out_tile(F, it >> 7, it & 127); __syncthreads(); } SEAM(4);
    if (IN(5)) {
        pg8::Gemm g{(const bf16_t*)(F.ws + WS_Y), (const bf16_t*)(F.ws + WS_WOUT), T, D, D, nullptr}; pg8::StaticOrder S; S.init(T, D, F.G, F.blk);
        pg8::EpiP5 E{F.x, (bf16_t*)(F.ws + WS_HB), (float*)(F.ws + WS_HSQ)};
        pg8::gemm_phase<pg8::EpiP5, pg8::StaticOrder, false>(F.lds, g, S, E);
    } SEAM(5);
    if (IN(6)) { router_phase(F); } SEAM(6);
    if (IN(7) || IN(8)) {
        LAS int* tbl = (LAS int*)(F.lds + TBL_OFF);
        __syncthreads();
        if (F.tid == 0) { int acc = 0; const unsigned* GCNT = ctl + CW_GCNT;
            for (int e = 0; e < NE; ++e) { const int cnt = (int)__hip_atomic_load(GCNT + e, __ATOMIC_RELAXED, __HIP_MEMORY_SCOPE_AGENT); tbl[e] = acc; tbl[33 + e] = cnt; acc += (cnt + 255) >> 8; }
            tbl[32] = acc; }
        __syncthreads();
        if (IN(7)) {
            pg8::Gemm g{(const bf16_t*)(F.ws + WS_HB), (const bf16_t*)(F.ws + WS_WGU), 0, 0, D, (const unsigned*)(F.ws + WS_LIST)};
            pg8::MoeOrder S{tbl, tbl[32] * 4, F.G, F.blk};
            pg8::EpiGU E{(const float*)(F.ws + WS_SRSTD), (bf16_t*)(F.ws + WS_HID)};
            pg8::gemm_phase<pg8::EpiGU, pg8::MoeOrder, true>(F.lds, g, S, E);
        }
        SEAM(7);
        if (IN(8)) {
            pg8::Gemm g{(const bf16_t*)(F.ws + WS_HID), (const bf16_t*)(F.ws + WS_WD), 0, 0, DFF, nullptr};
            pg8::MoeOrder S{tbl, tbl[32] * 4, F.G, F.blk};
            pg8::EpiDown E{(const unsigned*)(F.ws + WS_LIST), (const float*)(F.ws + WS_SW), (bf16_t*)(F.ws + WS_YE)};
            pg8::gemm_phase<pg8::EpiDown, pg8::MoeOrder, false>(F.lds, g, S, E);
        }
    }
    SEAM(8);
    if (IN(9)) { final_phase(F); }
    if (lo >= 20 && lo < 30) { if (MK_DBG_TELE >= 100) dbg_msq_phase(F, lo - 20); else dbg_check_phase(F, lo - 20); }
    if (lo == 30) dbg_tele_out(F);
#undef IN
#undef SEAM
}

extern "C" void kernel_launch(void* const* d_in, const int* in_sizes, int n_in, void* d_out, int out_size, void* d_ws, size_t ws_size, hipStream_t stream) {
    static int grid = 0;
    if (grid == 0) {
        if (n_in != 21 || out_size != T * D || ws_size < WS_END) { fprintf(stderr, "kernel_launch: unexpected shapes (n_in %d, out %d, ws %zu)\n", n_in, out_size, ws_size); grid = -1; return; }
        int dev = 0, cus = 0, per_cu = 0;
        if (hipGetDevice(&dev) != hipSuccess || hipDeviceGetAttribute(&cus, hipDeviceAttributeMultiprocessorCount, dev) != hipSuccess) { grid = -1; return; }
        if (hipFuncSetAttribute((const void*)mk_fwd, hipFuncAttributeMaxDynamicSharedMemorySize, LDS_BYTES) != hipSuccess) { fprintf(stderr, "kernel_launch: hipFuncSetAttribute failed\n"); grid = -1; return; }
        if (hipOccupancyMaxActiveBlocksPerMultiprocessor(&per_cu, (const void*)mk_fwd, NWAVES * 64, LDS_BYTES) != hipSuccess || per_cu < 1) { fprintf(stderr, "kernel_launch: occupancy query says %d blocks/CU\n", per_cu); (void)hipGetLastError(); grid = -1; return; }
        grid = cus;
    }
    if (grid < 0) return;
    (void)hipMemsetAsync((char*)d_ws + WS_CTL, 0, CTL_ZERO_BYTES, stream);
    Args a{};
    for (int i = 0; i < 21; ++i) a.in[i] = (const float*)d_in[i];
    a.out = (float*)d_out; a.ws = (unsigned char*)d_ws;
    if (MK_N_LAUNCHES == 1) {
        a.ph_lo = 0; a.ph_hi = NPHASES;
        hipLaunchKernelGGL(mk_fwd, dim3(grid), dim3(NWAVES * 64), LDS_BYTES, stream, a);
    } else {
        for (int p = 0; p < MK_DBG_NPH; ++p) { a.ph_lo = p; a.ph_hi = p + 1; hipLaunchKernelGGL(mk_fwd, dim3(grid), dim3(NWAVES * 64), LDS_BYTES, stream, a);
            if (MK_DBG_TELE) { a.ph_lo = 20 + p; a.ph_hi = 21 + p; hipLaunchKernelGGL(mk_fwd, dim3(grid), dim3(NWAVES * 64), LDS_BYTES, stream, a); } }
        if (MK_DBG_TELE) { a.ph_lo = 30; a.ph_hi = 31; hipLaunchKernelGGL(mk_fwd, dim3(grid), dim3(NWAVES * 64), LDS_BYTES, stream, a); }
    }
}
```

```cpp
#include <hip/hip_runtime.h>
#include <cstdio>
#include <cstdint>

#ifndef MK_N_LAUNCHES
#define MK_N_LAUNCHES 1
#endif

#ifndef MK_DBG_TELE
#define MK_DBG_TELE 0
#endif
#ifndef MK_DBG_MOE
#define MK_DBG_MOE 1.0f
#endif
#define LAS __attribute__((address_space(3)))
typedef unsigned short bf16_t;
typedef short bf16x8 __attribute__((ext_vector_type(8)));
typedef float f32x4 __attribute__((ext_vector_type(4)));
typedef float f32x2 __attribute__((ext_vector_type(2)));
typedef unsigned u32x4 __attribute__((ext_vector_type(4)));
typedef unsigned u32x2 __attribute__((ext_vector_type(2)));

constexpr int T = 32768, D = 1024, SEQ = 8192, NPROJ = 3072, DIN = 3080;
constexpr int NE = 32, DFF = 512, CAP = 65536;
constexpr float EPS = 1e-6f;
constexpr int NWAVES = 8;

constexpr size_t MiB = 1u << 20;
constexpr size_t WS_CTL = 0, CTL_ZERO_BYTES = 256 * 1024;
constexpr size_t WS_IFP = 1 * MiB;
constexpr size_t WS_CHSC = 2 * MiB;
constexpr size_t WS_MST = 2 * MiB + 65536;
constexpr size_t WS_NST = 3 * MiB;
constexpr size_t WS_HSQ = 4 * MiB;
constexpr size_t WS_WR = 6 * MiB;
constexpr size_t WS_WSP = 6 * MiB + 512 * 1024;
constexpr size_t WS_LIST = 8 * MiB;
constexpr size_t WS_SRSTD = 16 * MiB;
constexpr size_t WS_SW = 24 * MiB;
constexpr size_t WS_WIN = 32 * MiB;
constexpr size_t WS_WOUT = 38 * MiB;
constexpr size_t WS_WGU = 40 * MiB;
constexpr size_t WS_WD = 104 * MiB;
constexpr size_t WS_XN = 136 * MiB;
constexpr size_t WS_Y = 136 * MiB;
constexpr size_t WS_PROJ = 200 * MiB;
constexpr size_t WS_YE = 200 * MiB;
constexpr size_t WS_HB = 328 * MiB;
constexpr size_t WS_CST = 392 * MiB;
constexpr size_t WS_HID = 392 * MiB;
constexpr size_t WS_END = 464 * MiB;
constexpr int CW_GCNT = 64;
constexpr int CW_BAR = 4096;

constexpr int RING_BYTES = 131072;
constexpr int TBL_OFF = RING_BYTES;
constexpr int MISC_OFF = RING_BYTES + 1024;
constexpr int LDS_BYTES = 147456;

typedef __bf16 bf16x2_t __attribute__((ext_vector_type(2)));
__device__ __forceinline__ unsigned cvt_pk_bf16(float lo, float hi) { f32x2 v = {lo, hi}; bf16x2_t b = __builtin_convertvector(v, bf16x2_t); return __builtin_bit_cast(unsigned, b); }
__device__ __forceinline__ unsigned f2bf(float f) { unsigned u = __builtin_bit_cast(unsigned, f); return (u + 0x7fffu + ((u >> 16) & 1u)) >> 16; }
__device__ __forceinline__ float bflo(unsigned w) { return __builtin_bit_cast(float, w << 16); }
__device__ __forceinline__ float bfhi(unsigned w) { return __builtin_bit_cast(float, w & 0xffff0000u); }
__device__ __forceinline__ float sigmoid_f(float x) { return 1.0f / (1.0f + __expf(-x)); }
__device__ __forceinline__ float silu_f(float x) { return x / (1.0f + __expf(-x)); }
__device__ __forceinline__ float gelu_f(float x) { const float u = 0.7978845608028654f * (x + 0.044715f * x * x * x); return x / (1.0f + __expf(-2.0f * u)); }
__device__ __forceinline__ void unpack8(const u32x4 r, float (&v)[8]) { v[0] = bflo(r.x); v[1] = bfhi(r.x); v[2] = bflo(r.y); v[3] = bfhi(r.y); v[4] = bflo(r.z); v[5] = bfhi(r.z); v[6] = bflo(r.w); v[7] = bfhi(r.w); }
__device__ __forceinline__ float wave_sum(float v) {
#pragma unroll
    for (int o = 1; o < 64; o <<= 1) v += __shfl_xor(v, o);
    return v;
}
__device__ __forceinline__ float wave_max(float v) {
#pragma unroll
    for (int o = 1; o < 64; o <<= 1) v = fmaxf(v, __shfl_xor(v, o));
    return v;
}
#define MFMA16(a, b, c) __builtin_amdgcn_mfma_f32_16x16x32_bf16((a), (b), (c), 0, 0, 0)
#define LDS_WAIT() asm volatile("s_waitcnt lgkmcnt(0)" ::: "memory")
#define VM_WAIT() asm volatile("s_waitcnt vmcnt(0)" ::: "memory")

namespace pg8 {
constexpr int BM = 256, BK = 64, HALF = 128, HTB = HALF * BK * 2, STAGE_BYTES = 8 * HTB, NXCD = 8, WGM = 8;
__host__ __device__ __forceinline__ int lds_byte(int r, int c) { const int st = (r >> 4) * 2 + (c >> 5), rr = r & 15, cc = c & 31, ob = rr * 64 + cc * 2; return st * 1024 + (ob ^ (((ob >> 9) & 1) << 5)); }
__host__ __device__ __forceinline__ void stage_rc(int b, int& R, int& C) { const int st = b / 1024, sb = b % 1024, swz = sb ^ (((sb >> 9) & 1) << 5); R = (st >> 1) * 16 + swz / 64; C = (st & 1) * 32 + (swz % 64) / 2; }
__host__ __device__ __forceinline__ int perm32(int rho) { const int n = rho >> 4, i = rho & 15; return 8 * (i >> 2) + 4 * n + (i & 3); }

struct Unit { int pm, pn, lbase, nvalid; };
struct Gemm { const bf16_t* A; const bf16_t* Bt; int M, N, K; const unsigned* list; };

struct StaticOrder {
    int nM, nN, nwg, G, c;
    __device__ void init(int M, int N, int G_, int c_) { nM = M / BM; nN = N / BM; nwg = nM * nN; G = G_; c = c_; }
    __device__ bool next(int i, Unit& u) const {
        const long L = (long)i * G + c; if (L >= nwg) return false;
        int wgid = (int)L; { const int q = nwg / NXCD, r = nwg % NXCD, xcd = wgid % NXCD, off = wgid / NXCD; wgid = (xcd < r ? xcd * (q + 1) : r * (q + 1) + (xcd - r) * q) + off; }
        const int nig = WGM * nN, gid = wgid / nig, fm = gid * WGM, gsz = (nM - fm) < WGM ? (nM - fm) : WGM;
        u.pm = fm + ((wgid % nig) % gsz); u.pn = (wgid % nig) / gsz; u.lbase = 0; u.nvalid = 256; return true;
    }
};
struct MoeOrder {
    const LAS int* tbl; int nunits, G, c;
    __device__ bool next(int i, Unit& u) const {
        const long L = (long)i * G + c; if (L >= nunits) return false;
        int wgid = (int)L; { const int q = nunits / NXCD, r = nunits % NXCD, xcd = wgid % NXCD, off = wgid / NXCD; wgid = (xcd < r ? xcd * (q + 1) : r * (q + 1) + (xcd - r) * q) + off; }
        const int mt = wgid >> 2, pn = wgid & 3;
        int e = 0;
#pragma unroll
        for (int s = 16; s >= 1; s >>= 1) if (tbl[e + s] <= mt) e += s;
        const int lt = mt - tbl[e]; const int rem = tbl[33 + e] - lt * 256;
        u.pm = mt; u.pn = e * 4 + pn; u.lbase = e * CAP + lt * 256; u.nvalid = rem < 256 ? rem : 256; return true;
    }
};

struct EpiP1 {
    static constexpr bool PERM = true;
    bf16_t* O;
    __device__ __forceinline__ void operator()(const f32x4 (&acc)[2][2][4][2], const Unit& u, int wr, int wc, int fr, int fq) const {
        const int act = (u.pn < 6) ? 0 : (u.pn < 8 ? 1 : 2);
        const int row0 = u.pm * BM + wr * 64 + fr, col0 = u.pn * BM + wc * 32 + 8 * fq;
#pragma unroll
        for (int ai = 0; ai < 2; ++ai)
#pragma unroll
            for (int m = 0; m < 4; ++m) { bf16_t* rowp = O + (size_t)(row0 + ai * HALF + m * 16) * NPROJ + col0;
#pragma unroll
                for (int bj = 0; bj < 2; ++bj) { f32x4 v0 = acc[ai][bj][m][0], v1 = acc[ai][bj][m][1];
                    if (act == 1) {
#pragma unroll
                        for (int j = 0; j < 4; ++j) { v0[j] = sigmoid_f(v0[j]); v1[j] = sigmoid_f(v1[j]); }
                    } else if (act == 2) {
#pragma unroll
                        for (int j = 0; j < 4; ++j) { v0[j] = gelu_f(v0[j]); v1[j] = gelu_f(v1[j]); }
                    }
                    u32x4 w; w.x = cvt_pk_bf16(v0[0], v0[1]); w.y = cvt_pk_bf16(v0[2], v0[3]); w.z = cvt_pk_bf16(v1[0], v1[1]); w.w = cvt_pk_bf16(v1[2], v1[3]);
                    *(u32x4*)(rowp + bj * HALF) = w; } }
    }
};
struct EpiP5 {
    static constexpr bool PERM = true;
    const float* X; bf16_t* HB; float* HSQ;
    __device__ __forceinline__ void operator()(const f32x4 (&acc)[2][2][4][2], const Unit& u, int wr, int wc, int fr, int fq) const {
        const int row0 = u.pm * BM + wr * 64 + fr, col0 = u.pn * BM + wc * 32 + 8 * fq;
#pragma unroll
        for (int ai = 0; ai < 2; ++ai)
#pragma unroll
            for (int m = 0; m < 4; ++m) { const int row = row0 + ai * HALF + m * 16; float ss = 0.f;
#pragma unroll
                for (int bj = 0; bj < 2; ++bj) { const size_t off = (size_t)row * D + col0 + bj * HALF;
                    const f32x4 x0 = *(const f32x4*)(X + off), x1 = *(const f32x4*)(X + off + 4);
                    const f32x4 h0 = acc[ai][bj][m][0] + x0, h1 = acc[ai][bj][m][1] + x1;
                    ss += (h0[0] * h0[0] + h0[1] * h0[1]) + (h0[2] * h0[2] + h0[3] * h0[3]) + (h1[0] * h1[0] + h1[1] * h1[1]) + (h1[2] * h1[2] + h1[3] * h1[3]);
                    u32x4 w; w.x = cvt_pk_bf16(h0[0], h0[1]); w.y = cvt_pk_bf16(h0[2], h0[3]); w.z = cvt_pk_bf16(h1[0], h1[1]); w.w = cvt_pk_bf16(h1[2], h1[3]);
                    *(u32x4*)(HB + off) = w; }
                ss += __shfl_xor(ss, 16); ss += __shfl_xor(ss, 32);
                if (fq == 0) HSQ[(size_t)row * 16 + u.pn * 4 + wc] = ss; }
    }
};
struct EpiGU {
    static constexpr bool PERM = true;
    const float* SRSTD; bf16_t* HID;
    __device__ __forceinline__ void operator()(const f32x4 (&acc)[2][2][4][2], const Unit& u, int wr, int wc, int fr, int fq) const {
        const int col0 = (u.pn & 3) * 128 + wc * 32 + 8 * fq;
#pragma unroll
        for (int ai = 0; ai < 2; ++ai)
#pragma unroll
            for (int m = 0; m < 4; ++m) { const int lr = ai * HALF + wr * 64 + m * 16 + fr;
                const float rs = (lr < u.nvalid) ? SRSTD[u.lbase + lr] : 0.f;
                float hv[8];
#pragma unroll
                for (int n = 0; n < 2; ++n)
#pragma unroll
                    for (int j = 0; j < 4; ++j) { const float g = acc[ai][0][m][n][j] * rs, up = acc[ai][1][m][n][j] * rs; hv[n * 4 + j] = silu_f(g) * up; }
                u32x4 w; w.x = cvt_pk_bf16(hv[0], hv[1]); w.y = cvt_pk_bf16(hv[2], hv[3]); w.z = cvt_pk_bf16(hv[4], hv[5]); w.w = cvt_pk_bf16(hv[6], hv[7]);
                *(u32x4*)(HID + (size_t)(u.pm * BM + lr) * DFF + col0) = w; }
    }
};
struct EpiDown {
    static constexpr bool PERM = true;
    const unsigned* LIST; const float* SW; bf16_t* YE;
    __device__ __forceinline__ void operator()(const f32x4 (&acc)[2][2][4][2], const Unit& u, int wr, int wc, int fr, int fq) const {
        const int col0 = (u.pn & 3) * BM + wc * 32 + 8 * fq;
#pragma unroll
        for (int ai = 0; ai < 2; ++ai)
#pragma unroll
            for (int m = 0; m < 4; ++m) { const int lr = ai * HALF + wr * 64 + m * 16 + fr;
                if (lr < u.nvalid) { const unsigned pair = LIST[u.lbase + lr]; const float w8 = SW[u.lbase + lr];
                    bf16_t* rowp = YE + (size_t)pair * D + col0;
#pragma unroll
                    for (int bj = 0; bj < 2; ++bj) { const f32x4 v0 = acc[ai][bj][m][0] * w8, v1 = acc[ai][bj][m][1] * w8;
                        u32x4 w; w.x = cvt_pk_bf16(v0[0], v0[1]); w.y = cvt_pk_bf16(v0[2], v0[3]); w.z = cvt_pk_bf16(v1[0], v1[1]); w.w = cvt_pk_bf16(v1[2], v1[3]);
                        *(u32x4*)(rowp + bj * HALF) = w; } } }
    }
};

template <class Epi, class Sched, bool GATHER>
__device__ __forceinline__ void gemm_phase(LAS unsigned char* lds, const Gemm g, const Sched& S, const Epi& E) {
    const int tid = threadIdx.x, wid = __builtin_amdgcn_readfirstlane(tid >> 6), lane = tid & 63, wr = wid >> 2, wc = wid & 3, fr = lane & 15, fq = lane >> 4;
    const int K = g.K, nt = K / BK;
    unsigned voffB[2], vAc[2][2], vAn[2][2]; int sR[2], sC[2];
    const size_t kstep = (size_t)(BK * 2);
    const size_t hstep = (size_t)HALF * K * 2;
    const size_t tstep = 2 * hstep;
#pragma unroll
    for (int i = 0; i < 2; ++i) { int R, C; stage_rc(tid * 16 + i * 8192, R, C); const int Rb = Epi::PERM ? ((R & ~31) + perm32(R & 31)) : R;
        sR[i] = R; sC[i] = C; voffB[i] = (unsigned)(Rb * K + C) * 2u;
        vAc[0][i] = (unsigned)(R * K + C) * 2u; vAc[1][i] = vAc[0][i] + (unsigned)hstep; vAn[0][i] = vAc[0][i]; vAn[1][i] = vAc[1][i]; }
    const unsigned ldsw = (unsigned)wid * 1024u;
    const int aoff = lds_byte(wr * 64 + fr, fq * 8), boff = lds_byte(wc * 32 + fr, fq * 8);
#define PG8_SA(b, h) (((b) * 2 + (h)) * HTB)
#define PG8_SB(b, h) ((4 + (b) * 2 + (h)) * HTB)
#define PG8_STAGE(bufoff, gbase, voff) do { _Pragma("unroll") for (int _i = 0; _i < 2; ++_i) \
        __builtin_amdgcn_global_load_lds((const unsigned*)((const char*)(gbase) + (voff)[_i]), (LAS unsigned*)(lds + (bufoff) + ldsw + _i * 8192), 16, 0, 0); } while (0)
#define PG8_LDA(dst, b, h) do { _Pragma("unroll") for (int m = 0; m < 4; ++m) _Pragma("unroll") for (int k = 0; k < 2; ++k) dst[m][k] = *(const LAS bf16x8*)(lds + PG8_SA(b, h) + aoff + m * 2048 + k * 1024); } while (0)
#define PG8_LDB(dst, b, h) do { _Pragma("unroll") for (int n = 0; n < 2; ++n) _Pragma("unroll") for (int k = 0; k < 2; ++k) dst[n][k] = *(const LAS bf16x8*)(lds + PG8_SB(b, h) + boff + n * 2048 + k * 1024); } while (0)
#define PG8_MMA(ai, bj, At, Bt) do { __builtin_amdgcn_s_setprio(1); _Pragma("unroll") for (int m = 0; m < 4; ++m) _Pragma("unroll") for (int n = 0; n < 2; ++n) _Pragma("unroll") for (int k = 0; k < 2; ++k) \
        acc[ai][bj][m][n] = __builtin_amdgcn_mfma_f32_16x16x32_bf16(Bt[n][k], At[m][k], acc[ai][bj][m][n], 0, 0, 0); __builtin_amdgcn_s_setprio(0); } while (0)
#define PG8_WAIT_V(n) asm volatile("s_waitcnt vmcnt(" #n ")" ::: "memory")
#define PG8_WAIT_L(n) asm volatile("s_waitcnt lgkmcnt(" #n ")" ::: "memory")
#define PG8_BAR __builtin_amdgcn_s_barrier()
#define PG8_SCHED __builtin_amdgcn_sched_barrier(0)
#define PG8_GATHER(dst, un) do { _Pragma("unroll") for (int _h = 0; _h < 2; ++_h) _Pragma("unroll") for (int _i = 0; _i < 2; ++_i) { \
        const int _lr = _h * HALF + sR[_i]; unsigned _p = 0u; if (_lr < (un).nvalid) _p = g.list[(un).lbase + _lr]; \
        dst[_h][_i] = ((_p >> 1) * (unsigned)K + (unsigned)sC[_i]) * 2u; asm volatile("" : "+v"(dst[_h][_i])); } } while (0)
    Unit cur, nxt; int ui = 0;
    if (!S.next(0, cur)) return;
    f32x4 acc[2][2][4][2];
#pragma unroll
    for (int a = 0; a < 2; ++a)
#pragma unroll
        for (int b = 0; b < 2; ++b)
#pragma unroll
            for (int m = 0; m < 4; ++m)
#pragma unroll
                for (int n = 0; n < 2; ++n) acc[a][b][m][n] = (f32x4){0.f, 0.f, 0.f, 0.f};
    bf16x8 At[4][2], B0[2][2], B1[2][2];
    const char* cA = GATHER ? (const char*)g.A : (const char*)g.A + (size_t)cur.pm * tstep; const char* cB = (const char*)g.Bt + (size_t)cur.pn * tstep;
    if constexpr (GATHER) { PG8_GATHER(vAc, cur); }
    PG8_STAGE(PG8_SB(0, 0), cB, voffB); PG8_STAGE(PG8_SB(0, 1), cB + hstep, voffB); PG8_STAGE(PG8_SA(0, 0), cA, vAc[0]); PG8_STAGE(PG8_SA(0, 1), cA, vAc[1]);
    if (wr == 1) PG8_BAR;
    PG8_WAIT_V(2); PG8_BAR;
    PG8_STAGE(PG8_SB(1, 0), cB + kstep, voffB); PG8_STAGE(PG8_SA(1, 0), cA + kstep, vAc[0]); PG8_STAGE(PG8_SB(1, 1), cB + hstep + kstep, voffB);
    PG8_WAIT_V(6); PG8_BAR;
    for (;;) {
        const bool has_next = S.next(ui + 1, nxt);
        const char* nA = has_next ? (GATHER ? (const char*)g.A : (const char*)g.A + (size_t)nxt.pm * tstep) : cA; const char* nB = has_next ? (const char*)g.Bt + (size_t)nxt.pn * tstep : cB;
        if constexpr (GATHER) {
            if (has_next) { PG8_GATHER(vAn, nxt); }
            else {
#pragma unroll
                for (int h = 0; h < 2; ++h)
#pragma unroll
                    for (int i = 0; i < 2; ++i) vAn[h][i] = vAc[h][i];
            }
        }
        for (int t = 0; t < nt; t += 2) {
            const bool last = (t == nt - 2);
            const char* a1 = cA + (size_t)(t + 1) * kstep;
            const char* a2 = last ? nA : cA + (size_t)(t + 2) * kstep; const char* b2 = last ? nB : cB + (size_t)(t + 2) * kstep;
            const char* a3 = a2 + kstep; const char* b3 = b2 + kstep;
            unsigned vA2[2][2];
#pragma unroll
            for (int h = 0; h < 2; ++h)
#pragma unroll
                for (int i = 0; i < 2; ++i) vA2[h][i] = (GATHER && last) ? vAn[h][i] : vAc[h][i];
            PG8_LDB(B0, 0, 0); PG8_LDB(B1, 0, 1); PG8_SCHED; PG8_LDA(At, 0, 0); PG8_STAGE(PG8_SA(1, 1), a1, vAc[1]);
            PG8_WAIT_V(8); PG8_WAIT_L(0); PG8_BAR; PG8_MMA(0, 0, At, B0); PG8_MMA(0, 1, At, B1); PG8_BAR; PG8_SCHED;
            PG8_LDA(At, 0, 1); PG8_STAGE(PG8_SB(0, 0), b2, voffB); PG8_STAGE(PG8_SB(0, 1), b2 + hstep, voffB); PG8_STAGE(PG8_SA(0, 0), a2, vA2[0]);
            PG8_WAIT_V(8); PG8_WAIT_L(0); PG8_BAR; PG8_MMA(1, 0, At, B0); PG8_MMA(1, 1, At, B1); PG8_BAR; PG8_SCHED;
            PG8_LDB(B0, 1, 0); PG8_LDB(B1, 1, 1); PG8_SCHED; PG8_LDA(At, 1, 0); PG8_STAGE(PG8_SA(0, 1), a2, vA2[1]);
            PG8_WAIT_V(8); PG8_WAIT_L(0); PG8_BAR; PG8_MMA(0, 0, At, B0); PG8_MMA(0, 1, At, B1); PG8_BAR; PG8_SCHED;
            PG8_LDA(At, 1, 1); PG8_STAGE(PG8_SB(1, 0), b3, voffB); PG8_STAGE(PG8_SB(1, 1), b3 + hstep, voffB); PG8_STAGE(PG8_SA(1, 0), a3, vA2[0]);
            PG8_WAIT_V(8); PG8_WAIT_L(0); PG8_BAR; PG8_MMA(1, 0, At, B0); PG8_MMA(1, 1, At, B1); PG8_BAR; PG8_SCHED;
        }
        if (wr == 0) PG8_BAR;
        E(acc, cur, wr, wc, fr, fq);
        if (!has_next) break;
#pragma unroll
        for (int a = 0; a < 2; ++a)
#pragma unroll
            for (int b = 0; b < 2; ++b)
#pragma unroll
                for (int m = 0; m < 4; ++m)
#pragma unroll
                    for (int n = 0; n < 2; ++n) acc[a][b][m][n] = (f32x4){0.f, 0.f, 0.f, 0.f};
        cur = nxt; cA = nA; cB = nB; ++ui;
        if constexpr (GATHER) {
#pragma unroll
            for (int h = 0; h < 2; ++h)
#pragma unroll
                for (int i = 0; i < 2; ++i) vAc[h][i] = vAn[h][i];
        }
        if (wr == 1) PG8_BAR;
    }
    PG8_WAIT_V(0);
    PG8_BAR;
#undef PG8_SA
#undef PG8_SB
#undef PG8_STAGE
#undef PG8_LDA
#undef PG8_LDB
#undef PG8_MMA
#undef PG8_WAIT_V
#undef PG8_WAIT_L
#undef PG8_BAR
#undef PG8_SCHED
#undef PG8_GATHER
}
}

typedef __attribute__((address_space(1))) unsigned gu32;
#define XB_TMO      128
#define XB_XCNT(j)  (256  + 64 * (j))
#define XB_XSUB(j)  (1280 + 64 * (j))
#define XB_XGEN(j)  (2304 + 64 * (j))
#define XB_TOP      3328
#define XB_TOPGEN   3392
#define XCD_BAR_WORDS 3456
#define XB_SPIN_CAP (1u << 18)
__device__ __forceinline__ unsigned xb_ld(unsigned* p)              { return __hip_atomic_load(p, __ATOMIC_RELAXED, __HIP_MEMORY_SCOPE_AGENT); }
__device__ __forceinline__ unsigned xb_add(unsigned* p, unsigned v) { return __hip_atomic_fetch_add(p, v, __ATOMIC_RELAXED, __HIP_MEMORY_SCOPE_AGENT); }
__device__ __forceinline__ unsigned xb_xcc_id() { return (unsigned)__builtin_amdgcn_s_getreg((3 << 11) | 20) & 0xFu; }
#define XB_SPIN(cond, bar) do { unsigned _sp = 0; while (cond) { __builtin_amdgcn_s_sleep(1); \
    if ((++_sp & 255u) == 0u) { if (xb_ld(&(bar)[XB_TMO])) break; if (_sp > XB_SPIN_CAP) { atomicAdd(&(bar)[XB_TMO], 1u); break; } } } } while (0)
struct XcdBarrier { unsigned* bar; unsigned x; volatile LAS unsigned* st; };
__device__ __forceinline__ XcdBarrier xcd_barrier_post(unsigned* bar, volatile LAS unsigned* st) {
    XcdBarrier b; b.bar = bar; b.x = xb_xcc_id(); b.st = st;
    if (threadIdx.x == 0) (void)xb_add(&bar[XB_XCNT(b.x)], 1u);
    return b;
}
__device__ __forceinline__ void xcd_barrier_complete(unsigned* bar, unsigned x, unsigned& nloc, unsigned& nx) {
    const unsigned G = gridDim.x * gridDim.y * gridDim.z;
    unsigned sum, cnt, mine, sp = 0u;
    for (;;) {
        sum = 0u; cnt = 0u; mine = 0u;
#pragma unroll
        for (unsigned j = 0; j < 16; ++j) { const unsigned c = xb_ld(&bar[XB_XCNT(j)]); sum += c; cnt += (c > 0u) ? 1u : 0u; mine = (j == x) ? c : mine; }
        if (sum == G) break;
        __builtin_amdgcn_s_sleep(1);
        if ((++sp & 255u) == 0u) { if (xb_ld(&bar[XB_TMO])) break; if (sp > XB_SPIN_CAP) { atomicAdd(&bar[XB_TMO], 1u); break; } }
    }
    nloc = mine > 0u ? mine : 1u; nx = cnt > 0u ? cnt : 1u;
}
__device__ __forceinline__ void xcd_barrier(const XcdBarrier& b) {
    asm volatile("s_waitcnt vmcnt(0)" ::: "memory");
    __syncthreads();
    if (threadIdx.x == 0) {
        unsigned* bar = b.bar;
        __builtin_amdgcn_s_waitcnt(0);
        unsigned nloc = b.st[0], nx = b.st[1];
        if (nloc == 0u) { xcd_barrier_complete(bar, b.x, nloc, nx); b.st[0] = nloc; b.st[1] = nx; }
        const unsigned old = xb_add(&bar[XB_XSUB(b.x)], 1u);
        const unsigned gen = old / nloc;
        if (old + 1u == (gen + 1u) * nloc) {
            __builtin_amdgcn_fence(__ATOMIC_RELEASE, "agent");
            asm volatile("s_waitcnt vmcnt(0)" ::: "memory");
            const unsigned og = xb_add(&bar[XB_TOP], 1u);
            const unsigned tg = og / nx;
            if (og + 1u == (tg + 1u) * nx) xb_add(&bar[XB_TOPGEN], 1u);
            else XB_SPIN(xb_ld(&bar[XB_TOPGEN]) == tg, bar);
            __builtin_amdgcn_fence(__ATOMIC_ACQUIRE, "agent");
            xb_add(&bar[XB_XGEN(b.x)], 1u);
            asm volatile("s_waitcnt vmcnt(0)" ::: "memory");
        } else {
            XB_SPIN(xb_ld(&bar[XB_XGEN(b.x)]) == gen, bar);
            __builtin_amdgcn_fence(__ATOMIC_ACQUIRE, "agent");
            asm volatile("s_waitcnt vmcnt(0)" ::: "memory");
        }
    }
    __syncthreads();
}

struct Args { const float* in[21]; float* out; unsigned char* ws; int ph_lo, ph_hi; };
struct Frame {
    LAS unsigned char* lds; int tid, lane, wave, G, blk;
    const float *x, *norm1_g, *w_in, *conv_qk, *b_igate, *b_fgate, *g_mlstm_out, *g_gmlp_v, *w_spatial, *b_spatial, *g_gmlp_out, *w_out, *norm2_g,
        *w_rg, *b_rg, *w_re, *b_re, *w_gate, *w_up, *w_down, *final_g;
    float* out; unsigned char* ws;
};

__device__ __forceinline__ void transpose_item64(const float* W, int ldw, int col0, int k0, bf16_t* dst, int K, const float* kscale, LAS unsigned* Tt, int lane) {
    const int kp = lane >> 4, nc = lane & 15;
    f32x4 a[8], b[8];
    const float* src = W + (size_t)(k0 + 2 * kp) * ldw + col0 + 4 * nc;
#pragma unroll
    for (int r = 0; r < 8; ++r) { a[r] = *(const f32x4*)(src + (size_t)(8 * r) * ldw); b[r] = *(const f32x4*)(src + (size_t)(8 * r + 1) * ldw); }
#pragma unroll
    for (int r = 0; r < 8; ++r) { float s0 = 1.f, s1 = 1.f; if (kscale) { s0 = kscale[k0 + 8 * r + 2 * kp]; s1 = kscale[k0 + 8 * r + 2 * kp + 1]; }
#pragma unroll
        for (int j = 0; j < 4; ++j) Tt[(4 * nc + j) * 32 + 4 * (r ^ (nc & 7)) + kp] = cvt_pk_bf16(a[r][j] * s0, b[r][j] * s1); }
    LDS_WAIT(); asm volatile("" ::: "memory");
#pragma unroll
    for (int i = 0; i < 8; ++i) { const int n = (lane >> 3) + 8 * i, c = lane & 7;
        const u32x4 v = *(const LAS u32x4*)(Tt + n * 32 + 4 * (c ^ ((n >> 2) & 7)));
        *(u32x4*)(dst + (size_t)n * K + k0 + 8 * c) = v; }
    LDS_WAIT(); asm volatile("" ::: "memory");
}
__device__ __forceinline__ void p0_prologue(Frame& F) {
    LAS unsigned* scr = (LAS unsigned*)(F.lds + F.wave * 8192);
    const int gw = F.blk * NWAVES + F.wave, NGW = F.G * NWAVES;
    bf16_t* WIN = (bf16_t*)(F.ws + WS_WIN); bf16_t* WOUT = (bf16_t*)(F.ws + WS_WOUT); bf16_t* WGU = (bf16_t*)(F.ws + WS_WGU); bf16_t* WD = (bf16_t*)(F.ws + WS_WD);
    constexpr int I_IN = 16 * 48, I_OUT = 16 * 16, I_E = 384, NITEMS = I_IN + I_OUT + NE * I_E;
    for (int it = gw; it < NITEMS; it += NGW) {
        int r = it;
        if (r < I_IN) { const int kb = r / 48, nb = r % 48, n0 = 64 * nb; transpose_item64(F.w_in, DIN, n0 < 2048 ? n0 : n0 + 8, 64 * kb, WIN + (size_t)n0 * D, D, nullptr, scr, F.lane); continue; }
        r -= I_IN;
        if (r < I_OUT) { const int kb = r / 16, nb = r % 16; transpose_item64(F.w_out, D, 64 * nb, 64 * kb, WOUT + (size_t)(64 * nb) * D, D, nullptr, scr, F.lane); continue; }
        r -= I_OUT;
        const int e = r / I_E; r -= e * I_E;
        if (r < 256) { const bool up = r >= 128; r &= 127; const int kb = r / 8, nb = r % 8, j0 = 64 * nb;
            const float* W = (up ? F.w_up : F.w_gate) + (size_t)e * D * DFF;
            transpose_item64(W, DFF, j0, 64 * kb, WGU + ((size_t)e * 1024 + 256 * (j0 >> 7) + (up ? 128 : 0) + (j0 & 127)) * D, D, F.norm2_g, scr, F.lane); continue; }
        r -= 256;
        { const int kb = r / 16, nb = r % 16; transpose_item64(F.w_down + (size_t)e * DFF * D, D, 64 * nb, 64 * kb, WD + ((size_t)e * 1024 + 64 * nb) * DFF, DFF, nullptr, scr, F.lane); }
    }
    { const int gt = F.blk * 512 + F.tid, NT_ = F.G * 512; bf16_t* WR = (bf16_t*)(F.ws + WS_WR); bf16_t* WSP = (bf16_t*)(F.ws + WS_WSP);
        for (int i = gt; i < 48 * 1024; i += NT_) { const int n = i >> 10, k = i & 1023; float v = 0.f;
            if (n < 4) v = F.w_rg[k * 4 + n] * F.norm2_g[k]; else if (n < 36) v = F.w_re[k * 32 + (n - 4)] * F.norm2_g[k];
            WR[i] = (bf16_t)f2bf(v); }
        for (int i = gt; i < 8 * 128 * 128; i += NT_) { const int tt = (i >> 7) & 127, s = i & 127; WSP[i] = (bf16_t)f2bf(s <= tt ? F.w_spatial[i] : 0.f); } }
    {
        float wif[4][4][8];
#pragma unroll
        for (int j = 0; j < 4; ++j)
#pragma unroll
            for (int e = 0; e < 4; ++e) { const float* p = F.w_in + (size_t)(256 * j + 4 * F.lane + e) * DIN + 2048; const f32x4 a = *(const f32x4*)p, b = *(const f32x4*)(p + 4);
                wif[j][e][0] = a[0]; wif[j][e][1] = a[1]; wif[j][e][2] = a[2]; wif[j][e][3] = a[3]; wif[j][e][4] = b[0]; wif[j][e][5] = b[1]; wif[j][e][6] = b[2]; wif[j][e][7] = b[3]; }
        f32x4 g1[4];
#pragma unroll
        for (int j = 0; j < 4; ++j) g1[j] = *(const f32x4*)(F.norm1_g + 256 * j + 4 * F.lane);
        bf16_t* XN = (bf16_t*)(F.ws + WS_XN); float* IFP = (float*)(F.ws + WS_IFP);
        for (int m0 = gw; m0 < T; m0 += 2 * NGW) {
            f32x4 vv[2][4];
#pragma unroll
            for (int u = 0; u < 2; ++u) { const f32x4* xr = (const f32x4*)(F.x + (size_t)(m0 + u * NGW) * D) + F.lane;
#pragma unroll
                for (int j = 0; j < 4; ++j) vv[u][j] = xr[64 * j]; }
#pragma unroll
            for (int u = 0; u < 2; ++u) { const int m = m0 + u * NGW; f32x4 (&v)[4] = vv[u]; float s = 0.f;
#pragma unroll
                for (int j = 0; j < 4; ++j) s += (v[j][0] * v[j][0] + v[j][1] * v[j][1]) + (v[j][2] * v[j][2] + v[j][3] * v[j][3]);
                const float rstd = 1.0f / sqrtf(wave_sum(s) * (1.0f / D) + EPS);
                float dot[8];
#pragma unroll
                for (int n = 0; n < 8; ++n) dot[n] = 0.f;
                unsigned long long* o8 = (unsigned long long*)(XN + (size_t)m * D) + F.lane;
#pragma unroll
                for (int j = 0; j < 4; ++j) { v[j] = v[j] * rstd * g1[j];
#pragma unroll
                    for (int e = 0; e < 4; ++e)
#pragma unroll
                        for (int n = 0; n < 8; ++n) dot[n] += v[j][e] * wif[j][e][n];
                    o8[64 * j] = (unsigned long long)cvt_pk_bf16(v[j][0], v[j][1]) | ((unsigned long long)cvt_pk_bf16(v[j][2], v[j][3]) << 32); }
#pragma unroll
                for (int n = 0; n < 8; ++n) dot[n] = wave_sum(dot[n]);
                if (F.lane < 8) { float val = 0.f;
#pragma unroll
                    for (int n = 0; n < 8; ++n) if (F.lane == n) val = dot[n];
                    if (F.lane < 4) val += F.b_igate[F.lane];
                    else { const float f = val + F.b_fgate[F.lane - 4]; val = (f >= 0.f) ? -log1pf(expf(-f)) : (f - log1pf(expf(f))); }
                    IFP[(size_t)m * 8 + F.lane] = val; } }
        }
    }
}

__device__ __forceinline__ void conv2rows(const bf16_t* PROJ, const float* conv_w, int trow0, int seqpos0, int r0, int col, float scale, float (&o0)[8], float (&o1)[8]) {
    float xr[5][8];
#pragma unroll
    for (int i = 0; i < 5; ++i) { const int r = r0 - 3 + i;
        if (seqpos0 + r >= 0) { const u32x4 raw = *(const u32x4*)(PROJ + (size_t)(trow0 + r) * NPROJ + col); unpack8(raw, xr[i]); }
        else {
#pragma unroll
            for (int j = 0; j < 8; ++j) xr[i][j] = 0.f;
        } }
    float cw[4][8];
#pragma unroll
    for (int i = 0; i < 4; ++i) { const f32x4 a = *(const f32x4*)(conv_w + i * 1024 + col), b = *(const f32x4*)(conv_w + i * 1024 + col + 4);
        cw[i][0] = a[0]; cw[i][1] = a[1]; cw[i][2] = a[2]; cw[i][3] = a[3]; cw[i][4] = b[0]; cw[i][5] = b[1]; cw[i][6] = b[2]; cw[i][7] = b[3]; }
#pragma unroll
    for (int j = 0; j < 8; ++j) {
        const float y0 = cw[0][j] * xr[0][j] + cw[1][j] * xr[1][j] + cw[2][j] * xr[2][j] + cw[3][j] * xr[3][j];
        const float y1 = cw[0][j] * xr[1][j] + cw[1][j] * xr[2][j] + cw[2][j] * xr[3][j] + cw[3][j] * xr[4][j];
        o0[j] = silu_f(y0) * scale; o1[j] = silu_f(y1) * scale; }
}

constexpr int TS64 = 144;
constexpr int TS128 = 272;
__device__ __forceinline__ void mlstm_local_tile(Frame& F, int bh, int c) {
    const bf16_t* PROJ = (const bf16_t*)(F.ws + WS_PROJ); const float* IFP = (const float*)(F.ws + WS_IFP);
    bf16_t* CST = (bf16_t*)(F.ws + WS_CST); float* NST = (float*)(F.ws + WS_NST); float* CHSC = (float*)(F.ws + WS_CHSC);
    LAS unsigned char* KT = F.lds; LAS unsigned char* VWT = F.lds + 18432; LAS float* WSV = (LAS float*)(F.lds + 36864);
    const int b = bh >> 2, h = bh & 3, trow0 = b * SEQ + c * 64, tid = F.tid, lane = F.lane;
    __syncthreads();
    if (F.wave == 0) {
        const int t = trow0 + lane;
        const float ig = IFP[(size_t)t * 8 + h], lf = IFP[(size_t)t * 8 + 4 + h];
        float bc = lf;
#pragma unroll
        for (int o = 1; o < 64; o <<= 1) { const float v = __shfl_up(bc, o); if (lane >= o) bc += v; }
        const float blast = __shfl(bc, 63);
        const float wst = blast - bc + ig;
        const float mloc = wave_max(wst);
        WSV[lane] = __expf(wst - mloc);
        if (lane == 0) { CHSC[(bh * 128 + c) * 2] = blast; CHSC[(bh * 128 + c) * 2 + 1] = mloc; }
    }
    const int ch = tid & 15, g = tid >> 4;
    {
        float k0[8], k1[8];
        conv2rows(PROJ, F.conv_qk, trow0, c * 64, 2 * g, 512 + h * 128 + 8 * ch, 0.08838834764831845f, k0, k1);
#pragma unroll
        for (int j = 0; j < 8; ++j) *(LAS unsigned*)(KT + (8 * ch + j) * TS64 + 4 * g) = cvt_pk_bf16(k0[j], k1[j]);
    }
    __syncthreads();
    {
        const int col = 1024 + h * 128 + 8 * ch;
        float v0[8], v1[8];
        unpack8(*(const u32x4*)(PROJ + (size_t)(trow0 + 2 * g) * NPROJ + col), v0); unpack8(*(const u32x4*)(PROJ + (size_t)(trow0 + 2 * g + 1) * NPROJ + col), v1);
        const float w0 = WSV[2 * g], w1 = WSV[2 * g + 1];
#pragma unroll
        for (int j = 0; j < 8; ++j) *(LAS unsigned*)(VWT + (8 * ch + j) * TS64 + 4 * g) = cvt_pk_bf16(v0[j] * w0, v1[j] * w1);
    }
    __syncthreads();
    {
        const int fr = lane & 15, fq = lane >> 4, w = F.wave;
        bf16x8 yv[2];
#pragma unroll
        for (int kk = 0; kk < 2; ++kk) yv[kk] = *(const LAS bf16x8*)(VWT + (16 * w + fr) * TS64 + (32 * kk + 8 * fq) * 2);
        bf16_t* dst = CST + ((size_t)(bh * 128 + c) * 128 + 16 * w + fr) * 128;
#pragma unroll
        for (int dt = 0; dt < 8; ++dt) { f32x4 acc = (f32x4){0.f, 0.f, 0.f, 0.f};
#pragma unroll
            for (int kk = 0; kk < 2; ++kk) { const bf16x8 xk = *(const LAS bf16x8*)(KT + (16 * dt + fr) * TS64 + (32 * kk + 8 * fq) * 2); acc = MFMA16(xk, yv[kk], acc); }
            u32x2 o; o.x = cvt_pk_bf16(acc[0], acc[1]); o.y = cvt_pk_bf16(acc[2], acc[3]);
            *(u32x2*)(dst + 16 * dt + 4 * fq) = o; }
    }
    if (tid < 128) { float s = 0.f;
#pragma unroll
        for (int q8 = 0; q8 < 8; ++q8) { float kv[8]; unpack8(*(const LAS u32x4*)(KT + tid * TS64 + q8 * 16), kv);
#pragma unroll
            for (int j = 0; j < 8; ++j) s += kv[j] * WSV[q8 * 8 + j]; }
        NST[(size_t)(bh * 128 + c) * 128 + tid] = s; }
}

__device__ __forceinline__ void gmlp_tile(Frame& F, int tile) {
    const bf16_t* PROJ = (const bf16_t*)(F.ws + WS_PROJ); const bf16_t* WSP = (const bf16_t*)(F.ws + WS_WSP); bf16_t* Y = (bf16_t*)(F.ws + WS_Y);
    LAS unsigned char* VBT = F.lds; LAS unsigned char* WS_ = F.lds + 17408; LAS float* RST = (LAS float*)(F.lds + 52224);
    const int trow0 = tile * 128, tid = F.tid, lane = F.lane, w = F.wave, fr = lane & 15, fq = lane >> 4;
    __syncthreads();
    for (int r = 0; r < 16; ++r) { const int row = w * 16 + r; float v[8]; unpack8(*(const u32x4*)(PROJ + (size_t)(trow0 + row) * NPROJ + 2560 + 8 * lane), v);
        float s = 0.f;
#pragma unroll
        for (int j = 0; j < 8; ++j) s += v[j] * v[j];
        s = wave_sum(s); if (lane == 0) RST[row] = 1.0f / sqrtf(s * (1.0f / 512.0f) + EPS); }
    for (int g = 0; g < 8; ++g) {
        __syncthreads();
        {
            const int ch = tid & 7, rp = tid >> 3, col = 2560 + 64 * g + 8 * ch;
            float v0[8], v1[8];
            unpack8(*(const u32x4*)(PROJ + (size_t)(trow0 + 2 * rp) * NPROJ + col), v0); unpack8(*(const u32x4*)(PROJ + (size_t)(trow0 + 2 * rp + 1) * NPROJ + col), v1);
            const float r0 = RST[2 * rp], r1 = RST[2 * rp + 1];
            const f32x4 ga = *(const f32x4*)(F.g_gmlp_v + 64 * g + 8 * ch), gb = *(const f32x4*)(F.g_gmlp_v + 64 * g + 8 * ch + 4);
            const float gg[8] = {ga[0], ga[1], ga[2], ga[3], gb[0], gb[1], gb[2], gb[3]};
#pragma unroll
            for (int j = 0; j < 8; ++j) *(LAS unsigned*)(VBT + (8 * ch + j) * TS128 + 4 * rp) = cvt_pk_bf16(v0[j] * r0 * gg[j], v1[j] * r1 * gg[j]);
        }
#pragma unroll
        for (int i = 0; i < 4; ++i) { const int id = tid + 512 * i, row = id >> 4, c16 = id & 15;
            *(LAS u32x4*)(WS_ + row * TS128 + c16 * 16) = *(const u32x4*)(WSP + (size_t)(g * 128 + row) * 128 + c16 * 8); }
        __syncthreads();
        f32x4 acc[4];
#pragma unroll
        for (int ct = 0; ct < 4; ++ct) acc[ct] = (f32x4){0.f, 0.f, 0.f, 0.f};
#pragma unroll
        for (int kk = 0; kk < 4; ++kk) { const bf16x8 yw = *(const LAS bf16x8*)(WS_ + (16 * w + fr) * TS128 + (32 * kk + 8 * fq) * 2);
#pragma unroll
            for (int ct = 0; ct < 4; ++ct) { const bf16x8 xv = *(const LAS bf16x8*)(VBT + (16 * ct + fr) * TS128 + (32 * kk + 8 * fq) * 2); acc[ct] = MFMA16(xv, yw, acc[ct]); } }
        const int tt = 16 * w + fr, trow = trow0 + tt;
        const float bias = F.b_spatial[g * 128 + tt];
        float gv[4][4]; float ss = 0.f;
#pragma unroll
        for (int ct = 0; ct < 4; ++ct) { const u32x2 ur = *(const u32x2*)(PROJ + (size_t)trow * NPROJ + 2048 + 64 * g + 16 * ct + 4 * fq);
            const float uu[4] = {bflo(ur.x), bfhi(ur.x), bflo(ur.y), bfhi(ur.y)};
#pragma unroll
            for (int j = 0; j < 4; ++j) { gv[ct][j] = uu[j] * (acc[ct][j] + bias); ss += gv[ct][j] * gv[ct][j]; } }
        ss += __shfl_xor(ss, 16); ss += __shfl_xor(ss, 32);
        const float rs = 1.0f / sqrtf(ss * (1.0f / 64.0f) + EPS);
#pragma unroll
        for (int ct = 0; ct < 4; ++ct) { const f32x4 go = *(const f32x4*)(F.g_gmlp_out + 64 * g + 16 * ct + 4 * fq);
            u32x2 o; o.x = cvt_pk_bf16(gv[ct][0] * rs * go[0], gv[ct][1] * rs * go[1]); o.y = cvt_pk_bf16(gv[ct][2] * rs * go[2], gv[ct][3] * rs * go[3]);
            *(u32x2*)(Y + (size_t)trow * D + 512 + 64 * g + 16 * ct + 4 * fq) = o; }
    }
}

__device__ __forceinline__ void scan_phase(Frame& F) {
    const float* CHSC = (const float*)(F.ws + WS_CHSC); float* MST = (float*)(F.ws + WS_MST); float* NST = (float*)(F.ws + WS_NST);
    unsigned* CST = (unsigned*)(F.ws + WS_CST);
    LAS float* SA = (LAS float*)F.lds; LAS float* SB = SA + 128; LAS float* SCB = SB + 128;
    const int bh = F.blk >> 4, sub = F.blk & 15, tid = F.tid;
    __syncthreads();
    if (tid < 256) SCB[tid] = CHSC[bh * 256 + tid];
    __syncthreads();
    if (tid == 0) { float m = 0.f;
        for (int c = 0; c < 128; ++c) { const float blast = SCB[2 * c], mloc = SCB[2 * c + 1]; const float mn = fmaxf(blast + m, mloc);
            SA[c] = __expf(blast + m - mn); SB[c] = __expf(mloc - mn); if (sub == 0) MST[bh * 128 + c] = m; m = mn; } }
    __syncthreads();
    if (F.G == 256) {
        unsigned* p = CST + (size_t)bh * 128 * 8192 + sub * 512 + tid;
        float s0 = 0.f, s1 = 0.f;
        for (int c0 = 0; c0 < 128; c0 += 8) { unsigned kl[8];
#pragma unroll
            for (int i = 0; i < 8; ++i) kl[i] = p[(size_t)(c0 + i) * 8192];
#pragma unroll
            for (int i = 0; i < 8; ++i) { p[(size_t)(c0 + i) * 8192] = cvt_pk_bf16(s0, s1); const float a = SA[c0 + i], b = SB[c0 + i]; s0 = a * s0 + b * bflo(kl[i]); s1 = a * s1 + b * bfhi(kl[i]); } }
        if (sub == 0 && tid < 128) { float s = 0.f; float* q = NST + (size_t)bh * 128 * 128 + tid;
            for (int c = 0; c < 128; ++c) { const float nl = q[c * 128]; q[c * 128] = s; s = SA[c] * s + SB[c] * nl; } }
    }
}

__device__ __forceinline__ void mlstm_out_tile(Frame& F, int bh, int c) {
    const bf16_t* PROJ = (const bf16_t*)(F.ws + WS_PROJ); const float* IFP = (const float*)(F.ws + WS_IFP);
    const bf16_t* CST = (const bf16_t*)(F.ws + WS_CST); const float* NST = (const float*)(F.ws + WS_NST); const float* MST = (const float*)(F.ws + WS_MST);
    bf16_t* Y = (bf16_t*)(F.ws + WS_Y);
    LAS unsigned char* Q = F.lds; LAS unsigned char* QW = F.lds + 17408; LAS unsigned char* KK = F.lds + 34816; LAS unsigned char* VT = F.lds + 52224;
    LAS unsigned char* CS = F.lds + 72960; LAS unsigned char* P = F.lds + 112128; LAS float* SC = (LAS float*)(F.lds + 121344); LAS float* HBUF = (LAS float*)F.lds;
    LAS float* S_BC = SC, * S_A = SC + 64, * S_MT = SC + 128, * S_WI = SC + 192, * S_EN = SC + 256, * S_NQ = SC + 320;
    const int b = bh >> 2, h = bh & 3, trow0 = b * SEQ + c * 64, tid = F.tid, lane = F.lane, w = F.wave, fr = lane & 15, fq = lane >> 4;
    __syncthreads();
    if (w == 0) {
        const int t = trow0 + lane; const float mc = MST[bh * 128 + c];
        const float ig = IFP[(size_t)t * 8 + h], lf = IFP[(size_t)t * 8 + 4 + h];
        float bc = lf;
#pragma unroll
        for (int o = 1; o < 64; o <<= 1) { const float v = __shfl_up(bc, o); if (lane >= o) bc += v; }
        const float a = ig - bc; float pm = a;
#pragma unroll
        for (int o = 1; o < 64; o <<= 1) { const float v = __shfl_up(pm, o); if (lane >= o) pm = fmaxf(pm, v); }
        const float inter = bc + mc, mt = fmaxf(inter, bc + pm);
        S_BC[lane] = bc; S_A[lane] = a; S_MT[lane] = mt; S_WI[lane] = __expf(inter - mt); S_EN[lane] = __expf(-mt);
    }
    const int ch = tid & 15, g = tid >> 4;
    float q0[8], q1[8];
    conv2rows(PROJ, F.conv_qk, trow0, c * 64, 2 * g, h * 128 + 8 * ch, 1.0f, q0, q1);
    {
        float k0[8], k1[8];
        conv2rows(PROJ, F.conv_qk, trow0, c * 64, 2 * g, 512 + h * 128 + 8 * ch, 0.08838834764831845f, k0, k1);
        u32x4 o; o.x = cvt_pk_bf16(k0[0], k0[1]); o.y = cvt_pk_bf16(k0[2], k0[3]); o.z = cvt_pk_bf16(k0[4], k0[5]); o.w = cvt_pk_bf16(k0[6], k0[7]);
        *(LAS u32x4*)(KK + (2 * g) * TS128 + 16 * ch) = o;
        o.x = cvt_pk_bf16(k1[0], k1[1]); o.y = cvt_pk_bf16(k1[2], k1[3]); o.z = cvt_pk_bf16(k1[4], k1[5]); o.w = cvt_pk_bf16(k1[6], k1[7]);
        *(LAS u32x4*)(KK + (2 * g + 1) * TS128 + 16 * ch) = o;
        o.x = cvt_pk_bf16(q0[0], q0[1]); o.y = cvt_pk_bf16(q0[2], q0[3]); o.z = cvt_pk_bf16(q0[4], q0[5]); o.w = cvt_pk_bf16(q0[6], q0[7]);
        *(LAS u32x4*)(Q + (2 * g) * TS128 + 16 * ch) = o;
        o.x = cvt_pk_bf16(q1[0], q1[1]); o.y = cvt_pk_bf16(q1[2], q1[3]); o.z = cvt_pk_bf16(q1[4], q1[5]); o.w = cvt_pk_bf16(q1[6], q1[7]);
        *(LAS u32x4*)(Q + (2 * g + 1) * TS128 + 16 * ch) = o;
    }
    {
        const int col = 1024 + h * 128 + 8 * ch; float v0[8], v1[8];
        unpack8(*(const u32x4*)(PROJ + (size_t)(trow0 + 2 * g) * NPROJ + col), v0); unpack8(*(const u32x4*)(PROJ + (size_t)(trow0 + 2 * g + 1) * NPROJ + col), v1);
#pragma unroll
        for (int j = 0; j < 8; ++j) *(LAS unsigned*)(VT + (8 * ch + j) * TS64 + 4 * g) = cvt_pk_bf16(v0[j], v1[j]);
        *(LAS unsigned*)(VT + (128 + (tid >> 5)) * TS64 + 4 * (tid & 31)) = (tid < 32) ? 0x3F803F80u : 0u;
    }
    {
        const bf16_t* src = CST + (size_t)(bh * 128 + c) * 16384;
#pragma unroll
        for (int i = 0; i < 4; ++i) { const int id = tid + 512 * i, row = id >> 4, c16 = id & 15; *(LAS u32x4*)(CS + row * TS128 + c16 * 16) = *(const u32x4*)(src + row * 128 + c16 * 8); }
        if (tid < 64) { const float* ns = NST + (size_t)(bh * 128 + c) * 128 + 2 * tid; *(LAS unsigned*)(CS + 128 * TS128 + 4 * tid) = cvt_pk_bf16(ns[0], ns[1]); }
        else if (tid < 64 + 240) { const int id = tid - 64, row = 129 + (id >> 4), c16 = id & 15; *(LAS u32x4*)(CS + row * TS128 + c16 * 16) = (u32x4){0u, 0u, 0u, 0u}; }
    }
    __syncthreads();
    {
        const float w0 = S_WI[2 * g], w1 = S_WI[2 * g + 1];
        u32x4 o; o.x = cvt_pk_bf16(q0[0] * w0, q0[1] * w0); o.y = cvt_pk_bf16(q0[2] * w0, q0[3] * w0); o.z = cvt_pk_bf16(q0[4] * w0, q0[5] * w0); o.w = cvt_pk_bf16(q0[6] * w0, q0[7] * w0);
        *(LAS u32x4*)(QW + (2 * g) * TS128 + 16 * ch) = o;
        o.x = cvt_pk_bf16(q1[0] * w1, q1[1] * w1); o.y = cvt_pk_bf16(q1[2] * w1, q1[3] * w1); o.z = cvt_pk_bf16(q1[4] * w1, q1[5] * w1); o.w = cvt_pk_bf16(q1[6] * w1, q1[7] * w1);
        *(LAS u32x4*)(QW + (2 * g + 1) * TS128 + 16 * ch) = o;
    }
    {
        const int lt = w >> 1; const int l = 16 * lt + fr; const float bl = S_BC[l], ml = S_MT[l];
#pragma unroll
        for (int si = 0; si < 2; ++si) { const int st = 2 * (w & 1) + si; f32x4 acc = (f32x4){0.f, 0.f, 0.f, 0.f};
            if (st <= lt) {
#pragma unroll
                for (int kk = 0; kk < 4; ++kk) { const bf16x8 xk = *(const LAS bf16x8*)(KK + (16 * st + fr) * TS128 + (32 * kk + 8 * fq) * 2); const bf16x8 yq = *(const LAS bf16x8*)(Q + l * TS128 + (32 * kk + 8 * fq) * 2); acc = MFMA16(xk, yq, acc); }
            }
            float pv[4];
#pragma unroll
            for (int j = 0; j < 4; ++j) { const int s = 16 * st + 4 * fq + j; pv[j] = (s <= l) ? acc[j] * __expf(bl + S_A[s] - ml) : 0.f; }
            u32x2 o; o.x = cvt_pk_bf16(pv[0], pv[1]); o.y = cvt_pk_bf16(pv[2], pv[3]);
            *(LAS u32x2*)(P + l * TS64 + (16 * st + 4 * fq) * 2) = o; }
    }
    __syncthreads();
    f32x4 acc[4], accx = (f32x4){0.f, 0.f, 0.f, 0.f};
#pragma unroll
    for (int lt = 0; lt < 4; ++lt) { acc[lt] = (f32x4){0.f, 0.f, 0.f, 0.f};
#pragma unroll
        for (int kk = 0; kk < 2; ++kk) { const bf16x8 xv = *(const LAS bf16x8*)(VT + (16 * w + fr) * TS64 + (32 * kk + 8 * fq) * 2); const bf16x8 yp = *(const LAS bf16x8*)(P + (16 * lt + fr) * TS64 + (32 * kk + 8 * fq) * 2); acc[lt] = MFMA16(xv, yp, acc[lt]); }
#pragma unroll
        for (int kk = 0; kk < 4; ++kk) { const bf16x8 xc = *(const LAS bf16x8*)(CS + (16 * w + fr) * TS128 + (32 * kk + 8 * fq) * 2); const bf16x8 yq = *(const LAS bf16x8*)(QW + (16 * lt + fr) * TS128 + (32 * kk + 8 * fq) * 2); acc[lt] = MFMA16(xc, yq, acc[lt]); } }
    if (w < 4) {
#pragma unroll
        for (int kk = 0; kk < 2; ++kk) { const bf16x8 xv = *(const LAS bf16x8*)(VT + (128 + fr) * TS64 + (32 * kk + 8 * fq) * 2); const bf16x8 yp = *(const LAS bf16x8*)(P + (16 * w + fr) * TS64 + (32 * kk + 8 * fq) * 2); accx = MFMA16(xv, yp, accx); }
#pragma unroll
        for (int kk = 0; kk < 4; ++kk) { const bf16x8 xc = *(const LAS bf16x8*)(CS + (128 + fr) * TS128 + (32 * kk + 8 * fq) * 2); const bf16x8 yq = *(const LAS bf16x8*)(QW + (16 * w + fr) * TS128 + (32 * kk + 8 * fq) * 2); accx = MFMA16(xc, yq, accx); }
        if (fq == 0) S_NQ[16 * w + fr] = accx[0];
    }
    __syncthreads();
#pragma unroll
    for (int lt = 0; lt < 4; ++lt) *(LAS f32x4*)(HBUF + (16 * lt + fr) * 132 + 16 * w + 4 * fq) = acc[lt];
    __syncthreads();
    {
        const int l = tid >> 3, seg = tid & 7, t = trow0 + l;
        const float den = 1.0f / fmaxf(fabsf(S_NQ[l]), S_EN[l]);
        float ov[16]; { float t8[8]; unpack8(*(const u32x4*)(PROJ + (size_t)t * NPROJ + 1536 + h * 128 + 16 * seg), t8);
#pragma unroll
            for (int j = 0; j < 8; ++j) ov[j] = t8[j];
            unpack8(*(const u32x4*)(PROJ + (size_t)t * NPROJ + 1536 + h * 128 + 16 * seg + 8), t8);
#pragma unroll
            for (int j = 0; j < 8; ++j) ov[8 + j] = t8[j]; }
        float hv[16]; float ss = 0.f;
#pragma unroll
        for (int j4 = 0; j4 < 4; ++j4) { const f32x4 nv = *(const LAS f32x4*)(HBUF + l * 132 + 16 * seg + 4 * j4);
#pragma unroll
            for (int j = 0; j < 4; ++j) { const float x = nv[j] * den * ov[4 * j4 + j]; hv[4 * j4 + j] = x; ss += x * x; } }
        ss += __shfl_xor(ss, 1); ss += __shfl_xor(ss, 2); ss += __shfl_xor(ss, 4);
        const float rs = 1.0f / sqrtf(ss * (1.0f / 128.0f) + EPS);
        const float* gm = F.g_mlstm_out + h * 128 + 16 * seg;
#pragma unroll
        for (int j = 0; j < 16; ++j) hv[j] *= rs * gm[j];
        u32x4 o; o.x = cvt_pk_bf16(hv[0], hv[1]); o.y = cvt_pk_bf16(hv[2], hv[3]); o.z = cvt_pk_bf16(hv[4], hv[5]); o.w = cvt_pk_bf16(hv[6], hv[7]);
        *(u32x4*)(Y + (size_t)t * D + h * 128 + 16 * seg) = o;
        o.x = cvt_pk_bf16(hv[8], hv[9]); o.y = cvt_pk_bf16(hv[10], hv[11]); o.z = cvt_pk_bf16(hv[12], hv[13]); o.w = cvt_pk_bf16(hv[14], hv[15]);
        *(u32x4*)(Y + (size_t)t * D + h * 128 + 16 * seg + 8) = o;
    }
}

constexpr int WR_STR = 2064;
__device__ __forceinline__ void router_phase(Frame& F) {
    const bf16_t* HB = (const bf16_t*)(F.ws + WS_HB); const bf16_t* WR = (const bf16_t*)(F.ws + WS_WR); const float* HSQ = (const float*)(F.ws + WS_HSQ);
    unsigned* LIST = (unsigned*)(F.ws + WS_LIST); float* SRSTD = (float*)(F.ws + WS_SRSTD); float* SW = (float*)(F.ws + WS_SW); unsigned* GCNT = (unsigned*)(F.ws + WS_CTL) + CW_GCNT;
    LAS unsigned char* WRL = F.lds; LAS float* LOG = (LAS float*)(F.lds + 99072); LAS unsigned* CNT = (LAS unsigned*)(F.lds + 99072 + 26624); LAS unsigned* BASE = CNT + 32;
    const int tid = F.tid, lane = F.lane, w = F.wave, fr = lane & 15, fq = lane >> 4;
    for (int tb = F.blk; tb < T / 128; tb += F.G) {
        __syncthreads();
#pragma unroll
        for (int i = 0; i < 12; ++i) { const int id = tid + 512 * i, row = id >> 7, c16 = id & 127; *(LAS u32x4*)(WRL + row * WR_STR + c16 * 16) = *(const u32x4*)(WR + (size_t)row * 1024 + c16 * 8); }
        if (tid < 32) CNT[tid] = 0u;
        __syncthreads();
        const int t0 = tb * 128 + w * 16;
        f32x4 acc[3];
#pragma unroll
        for (int nt = 0; nt < 3; ++nt) acc[nt] = (f32x4){0.f, 0.f, 0.f, 0.f};
        const bf16_t* hrow = HB + (size_t)(t0 + fr) * D + 8 * fq;
#pragma unroll 8
        for (int kk = 0; kk < 32; ++kk) { const bf16x8 y = *(const bf16x8*)(hrow + 32 * kk);
#pragma unroll
            for (int nt = 0; nt < 3; ++nt) { const bf16x8 x = *(const LAS bf16x8*)(WRL + (16 * nt + fr) * WR_STR + (32 * kk + 8 * fq) * 2); acc[nt] = MFMA16(x, y, acc[nt]); } }
        LAS float* lg = LOG + w * (16 * 52);
#pragma unroll
        for (int nt = 0; nt < 3; ++nt) *(LAS f32x4*)(lg + fr * 52 + 16 * nt + 4 * fq) = acc[nt];
        __syncthreads();
        int e0 = 0, e1 = 0; unsigned r0 = 0, r1 = 0; float w0 = 0.f, w1 = 0.f, rstd = 0.f; const int t = t0 + lane;
        if (lane < 16) {
            float ss = 0.f;
#pragma unroll
            for (int i = 0; i < 4; ++i) { const f32x4 v = *(const f32x4*)(HSQ + (size_t)t * 16 + 4 * i); ss += (v[0] + v[1]) + (v[2] + v[3]); }
            rstd = 1.0f / sqrtf(ss * (1.0f / D) + EPS);
            const LAS float* L = lg + lane * 52;
            float gl[4]; int gs = 0; float gmx;
#pragma unroll
            for (int i = 0; i < 4; ++i) gl[i] = L[i] * rstd + F.b_rg[i];
            gmx = gl[0];
#pragma unroll
            for (int i = 1; i < 4; ++i) if (gl[i] > gmx) { gmx = gl[i]; gs = i; }
            float gsum = 0.f;
#pragma unroll
            for (int i = 0; i < 4; ++i) gsum += __expf(gl[i] - gmx);
            const float pg = 1.0f / gsum;
            float el[8];
#pragma unroll
            for (int i = 0; i < 8; ++i) el[i] = L[4 + gs * 8 + i] * rstd + F.b_re[gs * 8 + i];
            int i0 = 0; float m0 = el[0];
#pragma unroll
            for (int i = 1; i < 8; ++i) if (el[i] > m0) { m0 = el[i]; i0 = i; }
            int i1 = (i0 == 0) ? 1 : 0; float m1 = (i0 == 0) ? el[1] : el[0];
#pragma unroll
            for (int i = 1; i < 8; ++i) if (i != i0 && el[i] > m1) { m1 = el[i]; i1 = i; }
            const float ex = __expf(m1 - m0);
            w0 = pg / (1.0f + ex); w1 = pg * ex / (1.0f + ex);
            e0 = gs * 8 + i0; e1 = gs * 8 + i1;
            r0 = atomicAdd((unsigned*)&CNT[e0], 1u); r1 = atomicAdd((unsigned*)&CNT[e1], 1u);
        }
        __syncthreads();
        if (tid < 32) BASE[tid] = __hip_atomic_fetch_add(GCNT + tid, CNT[tid], __ATOMIC_RELAXED, __HIP_MEMORY_SCOPE_AGENT);
        __syncthreads();
        if (lane < 16) {
            const unsigned i0 = (unsigned)e0 * CAP + BASE[e0] + r0, i1 = (unsigned)e1 * CAP + BASE[e1] + r1;
            LIST[i0] = 2u * t; SRSTD[i0] = rstd; SW[i0] = w0;
            LIST[i1] = 2u * t + 1u; SRSTD[i1] = rstd; SW[i1] = w1;
        }
    }
}

__device__ __forceinline__ void final_phase(Frame& F) {
    const bf16_t* HB = (const bf16_t*)(F.ws + WS_HB); const bf16_t* YE = (const bf16_t*)(F.ws + WS_YE);
    const int gw = F.blk * NWAVES + F.wave, NGW = F.G * NWAVES, lane = F.lane;
    f32x4 fg[4];
#pragma unroll
    for (int i = 0; i < 4; ++i) fg[i] = *(const f32x4*)(F.final_g + 16 * lane + 4 * i);
    for (int m0 = gw; m0 < T; m0 += 2 * NGW) {
        u32x4 ra[2][2], rb[2][2], rc[2][2];
#pragma unroll
        for (int u = 0; u < 2; ++u) { const int m = m0 + u * NGW;
#pragma unroll
            for (int hh = 0; hh < 2; ++hh) { ra[u][hh] = *(const u32x4*)(HB + (size_t)m * D + 16 * lane + 8 * hh); rb[u][hh] = *(const u32x4*)(YE + (size_t)(2 * m) * D + 16 * lane + 8 * hh); rc[u][hh] = *(const u32x4*)(YE + (size_t)(2 * m + 1) * D + 16 * lane + 8 * hh); } }
#pragma unroll
        for (int u = 0; u < 2; ++u) { const int m = m0 + u * NGW; float v[16]; float s = 0.f;
#pragma unroll
            for (int hh = 0; hh < 2; ++hh) { float a[8], b[8], c[8]; unpack8(ra[u][hh], a); unpack8(rb[u][hh], b); unpack8(rc[u][hh], c);
#pragma unroll
                for (int j = 0; j < 8; ++j) { const float x = a[j] + b[j] + c[j]; v[8 * hh + j] = x; s += x * x; } }
            const float rstd = 1.0f / sqrtf(wave_sum(s) * (1.0f / D) + EPS);
            float* o = F.out + (size_t)m * D + 16 * lane;
#pragma unroll
            for (int i = 0; i < 4; ++i) { f32x4 r; r[0] = v[4 * i] * rstd * fg[i][0]; r[1] = v[4 * i + 1] * rstd * fg[i][1]; r[2] = v[4 * i + 2] * rstd * fg[i][2]; r[3] = v[4 * i + 3] * rstd * fg[i][3]; *(f32x4*)(o + 4 * i) = r; } }
    }
}

#ifndef MK_DBG_TELE
#define MK_DBG_TELE 0
#endif
constexpr int CW_TELE = 128;
__device__ __forceinline__ void dbg_count_bf16(Frame& F, const bf16_t* p, size_t n, int slot) {
    unsigned bad = 0; const size_t gt = (size_t)F.blk * 512 + F.tid, NT_ = (size_t)F.G * 512;
    for (size_t i = gt; i < n; i += NT_) { const float v = bflo((unsigned)p[i]); if (!(fabsf(v) < 1.0e6f)) ++bad; }
    if (bad) atomicAdd((unsigned*)(F.ws + WS_CTL) + CW_TELE + slot, bad);
}
__device__ __forceinline__ void dbg_count_f32(Frame& F, const float* p, size_t n, int slot) {
    unsigned bad = 0; const size_t gt = (size_t)F.blk * 512 + F.tid, NT_ = (size_t)F.G * 512;
    for (size_t i = gt; i < n; i += NT_) { const float v = p[i]; if (!(fabsf(v) < 1.0e6f)) ++bad; }
    if (bad) atomicAdd((unsigned*)(F.ws + WS_CTL) + CW_TELE + slot, bad);
}
__device__ __forceinline__ void dbg_check_phase(Frame& F, int p) {
    if (p == 0) { dbg_count_bf16(F, (const bf16_t*)(F.ws + WS_XN), (size_t)T * D, 1); dbg_count_f32(F, (const float*)(F.ws + WS_IFP), (size_t)T * 8, 2); dbg_count_bf16(F, (const bf16_t*)(F.ws + WS_WIN), (size_t)NPROJ * D, 3);
                  dbg_count_bf16(F, (const bf16_t*)(F.ws + WS_WGU), (size_t)NE * 1024 * D, 4); dbg_count_bf16(F, (const bf16_t*)(F.ws + WS_WD), (size_t)NE * 1024 * DFF, 5); dbg_count_bf16(F, (const bf16_t*)(F.ws + WS_WOUT), (size_t)D * D, 6); }
    if (p == 1) dbg_count_bf16(F, (const bf16_t*)(F.ws + WS_PROJ), (size_t)T * NPROJ, 7);
    if (p == 2) { dbg_count_bf16(F, (const bf16_t*)(F.ws + WS_CST), (size_t)2048 * 16384, 8); dbg_count_f32(F, (const float*)(F.ws + WS_NST), (size_t)2048 * 128, 9); dbg_count_f32(F, (const float*)(F.ws + WS_CHSC), (size_t)4096, 10); }
    if (p == 3) { dbg_count_bf16(F, (const bf16_t*)(F.ws + WS_CST), (size_t)2048 * 16384, 11); dbg_count_f32(F, (const float*)(F.ws + WS_NST), (size_t)2048 * 128, 12); dbg_count_f32(F, (const float*)(F.ws + WS_MST), (size_t)2048, 13); }
    if (p == 4) dbg_count_bf16(F, (const bf16_t*)(F.ws + WS_Y), (size_t)T * D, 14);
    if (p == 5) { dbg_count_bf16(F, (const bf16_t*)(F.ws + WS_HB), (size_t)T * D, 15); dbg_count_f32(F, (const float*)(F.ws + WS_HSQ), (size_t)T * 16, 16); }
    if (p == 8) dbg_count_bf16(F, (const bf16_t*)(F.ws + WS_YE), (size_t)2 * T * D, 17);
}
__device__ __forceinline__ void dbg_msq(Frame& F, size_t wsoff, int isf32, int rows, int ld, int c0, int nc) {
    float acc = 0.f; const size_t gt = (size_t)F.blk * 512 + F.tid, NT_ = (size_t)F.G * 512, n = (size_t)rows * nc;
    for (size_t i = gt; i < n; i += NT_) { const size_t r = i / nc, c = c0 + i % nc; float v = isf32 ? ((const float*)(F.ws + wsoff))[r * ld + c] : bflo((unsigned)((const bf16_t*)(F.ws + wsoff))[r * ld + c]);
        if (!(fabsf(v) < 1.0e6f)) v = 1.0e6f; acc += v * v; }
    acc = wave_sum(acc);
    if (F.lane == 0) atomicAdd((float*)(F.ws + WS_CTL) + CW_TELE + 40, acc / (float)n);
}
__device__ __forceinline__ void dbg_msq_phase(Frame& F, int p) {
    const int m = MK_DBG_TELE - 100;
    if (p == 0 && m == 0) dbg_msq(F, WS_XN, 0, T, D, 0, D);
    if (p == 0 && m == 1) dbg_msq(F, WS_WIN, 0, NPROJ, D, 0, D);
    if (p == 0 && m == 2) dbg_msq(F, WS_IFP, 1, T, 8, 0, 8);
    if (p == 1 && m == 3) dbg_msq(F, WS_PROJ, 0, T, NPROJ, 0, 1024);
    if (p == 1 && m == 4) dbg_msq(F, WS_PROJ, 0, T, NPROJ, 1024, 512);
    if (p == 1 && m == 5) dbg_msq(F, WS_PROJ, 0, T, NPROJ, 1536, 512);
    if (p == 1 && m == 6) dbg_msq(F, WS_PROJ, 0, T, NPROJ, 2048, 1024);
    if (p == 2 && m == 7) dbg_msq(F, WS_CST, 0, 2048 * 128, 128, 0, 128);
    if (p == 2 && m == 8) dbg_msq(F, WS_Y, 0, T, D, 512, 512);
    if (p == 3 && m == 9) dbg_msq(F, WS_CST, 0, 2048 * 128, 128, 0, 128);
    if (p == 4 && m == 10) dbg_msq(F, WS_Y, 0, T, D, 0, 512);
    if (p == 5 && m == 11) dbg_msq(F, WS_HB, 0, T, D, 0, D);
    if (p == 8 && m == 12) dbg_msq(F, WS_YE, 0, 2 * T, D, 0, D);
    if (p == 2 && m == 13) dbg_msq(F, WS_NST, 1, 2048, 128, 0, 128);
    if (p == 2 && m == 14) dbg_msq(F, WS_CHSC, 1, 2048, 2, 0, 2);
}
__device__ __forceinline__ void dbg_tele_out(Frame& F) {
    const unsigned* tc = (const unsigned*)(F.ws + WS_CTL) + CW_TELE; float val = 0.5f;
    if (MK_DBG_TELE == 1) { for (int sl = 1; sl < 32; ++sl) { const unsigned c = tc[sl]; if (c) { val = 100.0f * sl + (float)(31 - __builtin_clz(c)); break; } } }
    else if (MK_DBG_TELE >= 100) { val = 1000.0f * ((const float*)tc)[40]; }
    else { val = (float)tc[MK_DBG_TELE]; }
    const size_t gt = (size_t)F.blk * 512 + F.tid, NT_ = (size_t)F.G * 512;
    for (size_t i = gt; i < (size_t)T * D; i += NT_) F.out[i] = val;
}
constexpr int NPHASES = 10;
#ifndef MK_DBG_NPH
#define MK_DBG_NPH 10
#endif
__global__ void __launch_bounds__(NWAVES * 64, 2) mk_fwd(Args args) {
    extern __shared__ __attribute__((aligned(16))) unsigned char lds_raw[];
    Frame F;
    F.lds = (LAS unsigned char*)lds_raw;
    F.tid = threadIdx.x; F.lane = F.tid & 63; F.wave = __builtin_amdgcn_readfirstlane(F.tid >> 6); F.G = gridDim.x; F.blk = blockIdx.x;
    F.x = args.in[0]; F.norm1_g = args.in[1]; F.w_in = args.in[2]; F.conv_qk = args.in[3]; F.b_igate = args.in[4]; F.b_fgate = args.in[5]; F.g_mlstm_out = args.in[6];
    F.g_gmlp_v = args.in[7]; F.w_spatial = args.in[8]; F.b_spatial = args.in[9]; F.g_gmlp_out = args.in[10]; F.w_out = args.in[11]; F.norm2_g = args.in[12];
    F.w_rg = args.in[13]; F.b_rg = args.in[14]; F.w_re = args.in[15]; F.b_re = args.in[16]; F.w_gate = args.in[17]; F.w_up = args.in[18]; F.w_down = args.in[19]; F.final_g = args.in[20];
    F.out = args.out; F.ws = args.ws;
    volatile LAS unsigned* MISC = (volatile LAS unsigned*)(F.lds + MISC_OFF);
    for (int u = F.tid; u < (LDS_BYTES - TBL_OFF) / 4; u += NWAVES * 64) ((LAS unsigned*)(F.lds + TBL_OFF))[u] = 0u;
    __syncthreads();
    unsigned* ctl = (unsigned*)(F.ws + WS_CTL);
    XcdBarrier bar; bar.bar = ctl + CW_BAR; bar.x = 0; bar.st = nullptr;
    if (MK_N_LAUNCHES == 1) bar = xcd_barrier_post(ctl + CW_BAR, MISC + 8);
    const int lo = args.ph_lo, hi = args.ph_hi;
#define IN(k) (lo <= (k) && (k) < hi)
#define SEAM(k) do { if (IN(k) && IN((k) + 1)) xcd_barrier(bar); } while (0)

    if (IN(0)) { p0_prologue(F); } SEAM(0);
    if (IN(1)) {
        pg8::Gemm g{(const bf16_t*)(F.ws + WS_XN), (const bf16_t*)(F.ws + WS_WIN), T, NPROJ, D, nullptr}; pg8::StaticOrder S; S.init(T, NPROJ, F.G, F.blk);
        pg8::EpiP1 E{(bf16_t*)(F.ws + WS_PROJ)};
        pg8::gemm_phase<pg8::EpiP1, pg8::StaticOrder, false>(F.lds, g, S, E);
    } SEAM(1);
    if (IN(2)) {
        for (int it = F.blk; it < 2048 + 256; it += F.G) { if (it < 2048) mlstm_local_tile(F, it >> 7, it & 127); else gmlp_tile(F, it - 2048); }
    } SEAM(2);
    if (IN(3)) { scan_phase(F); } SEAM(3);
    if (IN(4)) { for (int it = F.blk; it < 2048; it += F.G) mlstm_out_tile(F, it >> 7, it & 127); __syncthreads(); } SEAM(4);
    if (IN(5)) {
        pg8::Gemm g{(const bf16_t*)(F.ws + WS_Y), (const bf16_t*)(F.ws + WS_WOUT), T, D, D, nullptr}; pg8::StaticOrder S; S.init(T, D, F.G, F.blk);
        pg8::EpiP5 E{F.x, (bf16_t*)(F.ws + WS_HB), (float*)(F.ws + WS_HSQ)};
        pg8::gemm_phase<pg8::EpiP5, pg8::StaticOrder, false>(F.lds, g, S, E);
    } SEAM(5);
    if (IN(6)) { router_phase(F); } SEAM(6);
    if (IN(7) || IN(8)) {
        LAS int* tbl = (LAS int*)(F.lds + TBL_OFF);
        __syncthreads();
        if (F.tid == 0) { int acc = 0; const unsigned* GCNT = ctl + CW_GCNT;
            for (int e = 0; e < NE; ++e) { const int cnt = (int)__hip_atomic_load(GCNT + e, __ATOMIC_RELAXED, __HIP_MEMORY_SCOPE_AGENT); tbl[e] = acc; tbl[33 + e] = cnt; acc += (cnt + 255) >> 8; }
            tbl[32] = acc; }
        __syncthreads();
        if (IN(7)) {
            pg8::Gemm g{(const bf16_t*)(F.ws + WS_HB), (const bf16_t*)(F.ws + WS_WGU), 0, 0, D, (const unsigned*)(F.ws + WS_LIST)};
            pg8::MoeOrder S{tbl, tbl[32] * 4, F.G, F.blk};
            pg8::EpiGU E{(const float*)(F.ws + WS_SRSTD), (bf16_t*)(F.ws + WS_HID)};
            pg8::gemm_phase<pg8::EpiGU, pg8::MoeOrder, true>(F.lds, g, S, E);
        }
        SEAM(7);
        if (IN(8)) {
            pg8::Gemm g{(const bf16_t*)(F.ws + WS_HID), (const bf16_t*)(F.ws + WS_WD), 0, 0, DFF, nullptr};
            pg8::MoeOrder S{tbl, tbl[32] * 4, F.G, F.blk};
            pg8::EpiDown E{(const unsigned*)(F.ws + WS_LIST), (const float*)(F.ws + WS_SW), (bf16_t*)(F.ws + WS_YE)};
            pg8::gemm_phase<pg8::EpiDown, pg8::MoeOrder, false>(F.lds, g, S, E);
        }
    }
    SEAM(8);
    if (IN(9)) { final_phase(F); }
    if (lo >= 20 && lo < 30) { if (MK_DBG_TELE >= 100) dbg_msq_phase(F, lo - 20); else dbg_check_phase(F, lo - 20); }
    if (lo == 30) dbg_tele_out(F);
#undef IN
#undef SEAM
}

extern "C" void kernel_launch(void* const* d_in, const int* in_sizes, int n_in, void* d_out, int out_size, void* d_ws, size_t ws_size, hipStream_t stream) {
    static int grid = 0;
    if (grid == 0) {
        if (n_in != 21 || out_size != T * D || ws_size < WS_END) { fprintf(stderr, "kernel_launch: unexpected shapes (n_in %d, out %d, ws %zu)\n", n_in, out_size, ws_size); grid = -1; return; }
        int dev = 0, cus = 0, per_cu = 0;
        if (hipGetDevice(&dev) != hipSuccess || hipDeviceGetAttribute(&cus, hipDeviceAttributeMultiprocessorCount, dev) != hipSuccess) { grid = -1; return; }
        if (hipFuncSetAttribute((const void*)mk_fwd, hipFuncAttributeMaxDynamicSharedMemorySize, LDS_BYTES) != hipSuccess) { fprintf(stderr, "kernel_launch: hipFuncSetAttribute failed\n"); grid = -1; return; }
        if (hipOccupancyMaxActiveBlocksPerMultiprocessor(&per_cu, (const void*)mk_fwd, NWAVES * 64, LDS_BYTES) != hipSuccess || per_cu < 1) { fprintf(stderr, "kernel_launch: occupancy query says %d blocks/CU\n", per_cu); (void)hipGetLastError(); grid = -1; return; }
        grid = cus;
    }
    if (grid < 0) return;
    (void)hipMemsetAsync((char*)d_ws + WS_CTL, 0, CTL_ZERO_BYTES, stream);
    Args a{};
    for (int i = 0; i < 21; ++i) a.in[i] = (const float*)d_in[i];
    a.out = (float*)d_out; a.ws = (unsigned char*)d_ws;
    if (MK_N_LAUNCHES == 1) {
        a.ph_lo = 0; a.ph_hi = NPHASES;
        hipLaunchKernelGGL(mk_fwd, dim3(grid), dim3(NWAVES * 64), LDS_BYTES, stream, a);
    } else {
        for (int p = 0; p < MK_DBG_NPH; ++p) { a.ph_lo = p; a.ph_hi = p + 1; hipLaunchKernelGGL(mk_fwd, dim3(grid), dim3(NWAVES * 64), LDS_BYTES, stream, a);
            if (MK_DBG_TELE) { a.ph_lo = 20 + p; a.ph_hi = 21 + p; hipLaunchKernelGGL(mk_fwd, dim3(grid), dim3(NWAVES * 64), LDS_BYTES, stream, a); } }
        if (MK_DBG_TELE) { a.ph_lo = 30; a.ph_hi = 31; hipLaunchKernelGGL(mk_fwd, dim3(grid), dim3(NWAVES * 64), LDS_BYTES, stream, a); }
    }
}
```

```cpp
#include <hip/hip_runtime.h>
#include <cstdio>
#include <cstdint>

#ifndef MK_N_LAUNCHES
#define MK_N_LAUNCHES 1
#endif

#ifndef MK_DBG_TELE
#define MK_DBG_TELE 0
#endif
#ifndef MK_DBG_MOE
#define MK_DBG_MOE 1.0f
#endif
#define LAS __attribute__((address_space(3)))
typedef unsigned short bf16_t;
typedef short bf16x8 __attribute__((ext_vector_type(8)));
typedef float f32x4 __attribute__((ext_vector_type(4)));
typedef float f32x2 __attribute__((ext_vector_type(2)));
typedef unsigned u32x4 __attribute__((ext_vector_type(4)));
typedef unsigned u32x2 __attribute__((ext_vector_type(2)));

constexpr int T = 32768, D = 1024, SEQ = 8192, NPROJ = 3072, DIN = 3080;
constexpr int NE = 32, DFF = 512, CAP = 65536;
constexpr float EPS = 1e-6f;
constexpr int NWAVES = 8;

constexpr size_t MiB = 1u << 20;
constexpr size_t WS_CTL = 0, CTL_ZERO_BYTES = 256 * 1024;
constexpr size_t WS_IFP = 1 * MiB;
constexpr size_t WS_CHSC = 2 * MiB;
constexpr size_t WS_MST = 2 * MiB + 65536;
constexpr size_t WS_NST = 3 * MiB;
constexpr size_t WS_HSQ = 4 * MiB;
constexpr size_t WS_WR = 6 * MiB;
constexpr size_t WS_WSP = 6 * MiB + 512 * 1024;
constexpr size_t WS_LIST = 8 * MiB;
constexpr size_t WS_SRSTD = 16 * MiB;
constexpr size_t WS_SW = 24 * MiB;
constexpr size_t WS_WIN = 32 * MiB;
constexpr size_t WS_WOUT = 38 * MiB;
constexpr size_t WS_WGU = 40 * MiB;
constexpr size_t WS_WD = 72 * MiB;
constexpr size_t WS_HB8 = 88 * MiB;
constexpr size_t WS_XN = 136 * MiB;
constexpr size_t WS_Y = 136 * MiB;
constexpr size_t WS_PROJ = 200 * MiB;
constexpr size_t WS_YE = 200 * MiB;
constexpr size_t WS_HB = 328 * MiB;
constexpr size_t WS_CST = 392 * MiB;
constexpr size_t WS_HID = 392 * MiB;
constexpr size_t WS_END = 464 * MiB;
constexpr int CW_GCNT = 64;
constexpr int CW_BAR = 4096;

constexpr int RING_BYTES = 131072;
constexpr int TBL_OFF = RING_BYTES;
constexpr int MISC_OFF = RING_BYTES + 1024;
constexpr int LDS_BYTES = 147456;

typedef __bf16 bf16x2_t __attribute__((ext_vector_type(2)));
__device__ __forceinline__ unsigned cvt_pk_bf16(float lo, float hi) { f32x2 v = {lo, hi}; bf16x2_t b = __builtin_convertvector(v, bf16x2_t); return __builtin_bit_cast(unsigned, b); }
__device__ __forceinline__ unsigned f2bf(float f) { unsigned u = __builtin_bit_cast(unsigned, f); return (u + 0x7fffu + ((u >> 16) & 1u)) >> 16; }
__device__ __forceinline__ float bflo(unsigned w) { return __builtin_bit_cast(float, w << 16); }
__device__ __forceinline__ float bfhi(unsigned w) { return __builtin_bit_cast(float, w & 0xffff0000u); }
__device__ __forceinline__ float sigmoid_f(float x) { return __builtin_amdgcn_rcpf(1.0f + __expf(-x)); }
__device__ __forceinline__ float silu_f(float x) { return x * __builtin_amdgcn_rcpf(1.0f + __expf(-x)); }
__device__ __forceinline__ float gelu_f(float x) { const float u = 0.7978845608028654f * (x + 0.044715f * x * x * x); return x * __builtin_amdgcn_rcpf(1.0f + __expf(-2.0f * u)); }
__device__ __forceinline__ void unpack8(const u32x4 r, float (&v)[8]) { v[0] = bflo(r.x); v[1] = bfhi(r.x); v[2] = bflo(r.y); v[3] = bfhi(r.y); v[4] = bflo(r.z); v[5] = bfhi(r.z); v[6] = bflo(r.w); v[7] = bfhi(r.w); }
__device__ __forceinline__ float wave_sum(float v) {
#pragma unroll
    for (int o = 1; o < 64; o <<= 1) v += __shfl_xor(v, o);
    return v;
}
__device__ __forceinline__ float wave_max(float v) {
#pragma unroll
    for (int o = 1; o < 64; o <<= 1) v = fmaxf(v, __shfl_xor(v, o));
    return v;
}
typedef int i32x4 __attribute__((ext_vector_type(4)));
typedef int i32x8 __attribute__((ext_vector_type(8)));
__device__ __forceinline__ unsigned cvt4_fp8(float a, float b, float c, float d) { int w = 0; w = __builtin_amdgcn_cvt_pk_fp8_f32(a, b, w, false); w = __builtin_amdgcn_cvt_pk_fp8_f32(c, d, w, true); return (unsigned)w; }
constexpr float FP8_WSCALE = 64.0f, FP8_ASCALE = 8.0f;
#define MFMA16(a, b, c) __builtin_amdgcn_mfma_f32_16x16x32_bf16((a), (b), (c), 0, 0, 0)
#define LDS_WAIT() asm volatile("s_waitcnt lgkmcnt(0)" ::: "memory")
#define VM_WAIT() asm volatile("s_waitcnt vmcnt(0)" ::: "memory")

namespace pg8 {
constexpr int BM = 256, BK = 64, HALF = 128, HTB = HALF * BK * 2, STAGE_BYTES = 8 * HTB, NXCD = 8, WGM = 8;
__host__ __device__ __forceinline__ int lds_byte(int r, int c) { const int st = (r >> 4) * 2 + (c >> 5), rr = r & 15, cc = c & 31, ob = rr * 64 + cc * 2; return st * 1024 + (ob ^ (((ob >> 9) & 1) << 5)); }
__host__ __device__ __forceinline__ void stage_rc(int b, int& R, int& C) { const int st = b / 1024, sb = b % 1024, swz = sb ^ (((sb >> 9) & 1) << 5); R = (st >> 1) * 16 + swz / 64; C = (st & 1) * 32 + (swz % 64) / 2; }
__host__ __device__ __forceinline__ int perm32(int rho) { const int n = rho >> 4, i = rho & 15; return 8 * (i >> 2) + 4 * n + (i & 3); }

struct Unit { int pm, pn, lbase, nvalid; };
struct Gemm { const bf16_t* A; const bf16_t* Bt; int M, N, K; const unsigned* list; };

struct StaticOrder {
    int nM, nN, nwg, G, c;
    __device__ void init(int M, int N, int G_, int c_) { nM = M / BM; nN = N / BM; nwg = nM * nN; G = G_; c = c_; }
    __device__ bool next(int i, Unit& u) const {
        const long L = (long)i * G + c; if (L >= nwg) return false;
        int wgid = (int)L; { const int q = nwg / NXCD, r = nwg % NXCD, xcd = wgid % NXCD, off = wgid / NXCD; wgid = (xcd < r ? xcd * (q + 1) : r * (q + 1) + (xcd - r) * q) + off; }
        const int nig = WGM * nN, gid = wgid / nig, fm = gid * WGM, gsz = (nM - fm) < WGM ? (nM - fm) : WGM;
        u.pm = fm + ((wgid % nig) % gsz); u.pn = (wgid % nig) / gsz; u.lbase = 0; u.nvalid = 256; return true;
    }
};
struct MoeOrder {
    const LAS int* tbl; int nunits, G, c;
    __device__ bool next(int i, Unit& u) const {
        const long L = (long)i * G + c; if (L >= nunits) return false;
        int wgid = (int)L; { const int q = nunits / NXCD, r = nunits % NXCD, xcd = wgid % NXCD, off = wgid / NXCD; wgid = (xcd < r ? xcd * (q + 1) : r * (q + 1) + (xcd - r) * q) + off; }
        const int mt = wgid >> 2, pn = wgid & 3;
        int e = 0;
#pragma unroll
        for (int s = 16; s >= 1; s >>= 1) if (tbl[e + s] <= mt) e += s;
        const int lt = mt - tbl[e]; const int rem = tbl[33 + e] - lt * 256;
        u.pm = mt; u.pn = e * 4 + pn; u.lbase = e * CAP + lt * 256; u.nvalid = rem < 256 ? rem : 256; return true;
    }
};

struct EpiP1 {
    static constexpr bool PERM = true;
    bf16_t* O;
    __device__ __forceinline__ void operator()(const f32x4 (&acc)[2][2][4][2], const Unit& u, int wr, int wc, int fr, int fq) const {
        const int act = (u.pn < 6) ? 0 : (u.pn < 8 ? 1 : 2);
        const int row0 = u.pm * BM + wr * 64 + fr, col0 = u.pn * BM + wc * 32 + 8 * fq;
#pragma unroll
        for (int ai = 0; ai < 2; ++ai)
#pragma unroll
            for (int m = 0; m < 4; ++m) { bf16_t* rowp = O + (size_t)(row0 + ai * HALF + m * 16) * NPROJ + col0;
#pragma unroll
                for (int bj = 0; bj < 2; ++bj) { f32x4 v0 = acc[ai][bj][m][0], v1 = acc[ai][bj][m][1];
                    if (act == 1) {
#pragma unroll
                        for (int j = 0; j < 4; ++j) { v0[j] = sigmoid_f(v0[j]); v1[j] = sigmoid_f(v1[j]); }
                    } else if (act == 2) {
#pragma unroll
                        for (int j = 0; j < 4; ++j) { v0[j] = gelu_f(v0[j]); v1[j] = gelu_f(v1[j]); }
                    }
                    u32x4 w; w.x = cvt_pk_bf16(v0[0], v0[1]); w.y = cvt_pk_bf16(v0[2], v0[3]); w.z = cvt_pk_bf16(v1[0], v1[1]); w.w = cvt_pk_bf16(v1[2], v1[3]);
                    *(u32x4*)(rowp + bj * HALF) = w; } }
    }
};
struct EpiP5 {
    static constexpr bool PERM = true;
    const float* X; bf16_t* HB; float* HSQ; unsigned char* HB8;
    __device__ __forceinline__ void operator()(const f32x4 (&acc)[2][2][4][2], const Unit& u, int wr, int wc, int fr, int fq) const {
        const int row0 = u.pm * BM + wr * 64 + fr, col0 = u.pn * BM + wc * 32 + 8 * fq;
#pragma unroll
        for (int ai = 0; ai < 2; ++ai)
#pragma unroll
            for (int m = 0; m < 4; ++m) { const int row = row0 + ai * HALF + m * 16; float ss = 0.f;
#pragma unroll
                for (int bj = 0; bj < 2; ++bj) { const size_t off = (size_t)row * D + col0 + bj * HALF;
                    const f32x4 x0 = *(const f32x4*)(X + off), x1 = *(const f32x4*)(X + off + 4);
                    const f32x4 h0 = acc[ai][bj][m][0] + x0, h1 = acc[ai][bj][m][1] + x1;
                    ss += (h0[0] * h0[0] + h0[1] * h0[1]) + (h0[2] * h0[2] + h0[3] * h0[3]) + (h1[0] * h1[0] + h1[1] * h1[1]) + (h1[2] * h1[2] + h1[3] * h1[3]);
                    u32x4 w; w.x = cvt_pk_bf16(h0[0], h0[1]); w.y = cvt_pk_bf16(h0[2], h0[3]); w.z = cvt_pk_bf16(h1[0], h1[1]); w.w = cvt_pk_bf16(h1[2], h1[3]);
                    *(u32x4*)(HB + off) = w;
                    u32x2 w8; w8.x = cvt4_fp8(h0[0] * FP8_ASCALE, h0[1] * FP8_ASCALE, h0[2] * FP8_ASCALE, h0[3] * FP8_ASCALE); w8.y = cvt4_fp8(h1[0] * FP8_ASCALE, h1[1] * FP8_ASCALE, h1[2] * FP8_ASCALE, h1[3] * FP8_ASCALE);
                    *(u32x2*)(HB8 + off) = w8; }
                ss += __shfl_xor(ss, 16); ss += __shfl_xor(ss, 32);
                if (fq == 0) HSQ[(size_t)row * 16 + u.pn * 4 + wc] = ss; }
    }
};
struct EpiGU {
    static constexpr bool PERM = true;
    const float* SRSTD; unsigned char* HID;
    __device__ __forceinline__ void operator()(const f32x4 (&acc)[2][2][4][2], const Unit& u, int wr, int wc, int fr, int fq) const {
        const int col0 = (u.pn & 3) * 128 + wc * 32 + 8 * fq;
#pragma unroll
        for (int ai = 0; ai < 2; ++ai)
#pragma unroll
            for (int m = 0; m < 4; ++m) { const int lr = ai * HALF + wr * 64 + m * 16 + fr;
                const float rs = (lr < u.nvalid) ? SRSTD[u.lbase + lr] * (1.0f / (FP8_WSCALE * FP8_ASCALE)) : 0.f;
                float hv[8];
#pragma unroll
                for (int n = 0; n < 2; ++n)
#pragma unroll
                    for (int j = 0; j < 4; ++j) { const float g = acc[ai][0][m][n][j] * rs, up = acc[ai][1][m][n][j] * rs; hv[n * 4 + j] = silu_f(g) * up; }
                u32x2 w; w.x = cvt4_fp8(hv[0] * FP8_ASCALE, hv[1] * FP8_ASCALE, hv[2] * FP8_ASCALE, hv[3] * FP8_ASCALE); w.y = cvt4_fp8(hv[4] * FP8_ASCALE, hv[5] * FP8_ASCALE, hv[6] * FP8_ASCALE, hv[7] * FP8_ASCALE);
                *(u32x2*)(HID + (size_t)(u.pm * BM + lr) * DFF + col0) = w; }
    }
};
struct EpiDown {
    static constexpr bool PERM = true;
    const unsigned* LIST; const float* SW; bf16_t* YE;
    __device__ __forceinline__ void operator()(const f32x4 (&acc)[2][2][4][2], const Unit& u, int wr, int wc, int fr, int fq) const {
        const int col0 = (u.pn & 3) * BM + wc * 32 + 8 * fq;
#pragma unroll
        for (int ai = 0; ai < 2; ++ai)
#pragma unroll
            for (int m = 0; m < 4; ++m) { const int lr = ai * HALF + wr * 64 + m * 16 + fr;
                if (lr < u.nvalid) { const unsigned pair = LIST[u.lbase + lr]; const float w8 = SW[u.lbase + lr] * (1.0f / (FP8_WSCALE * FP8_ASCALE));
                    bf16_t* rowp = YE + (size_t)pair * D + col0;
#pragma unroll
                    for (int bj = 0; bj < 2; ++bj) { const f32x4 v0 = acc[ai][bj][m][0] * w8, v1 = acc[ai][bj][m][1] * w8;
                        u32x4 w; w.x = cvt_pk_bf16(v0[0], v0[1]); w.y = cvt_pk_bf16(v0[2], v0[3]); w.z = cvt_pk_bf16(v1[0], v1[1]); w.w = cvt_pk_bf16(v1[2], v1[3]);
                        *(u32x4*)(rowp + bj * HALF) = w; } } }
    }
};

template <class Epi, class Sched, bool GATHER, bool FP8 = false>
__device__ __forceinline__ void gemm_phase(LAS unsigned char* lds, const Gemm g, const Sched& S, const Epi& E) {
    const int tid = threadIdx.x, wid = __builtin_amdgcn_readfirstlane(tid >> 6), lane = tid & 63, wr = wid >> 2, wc = wid & 3, fr = lane & 15, fq = lane >> 4;
    const int K = g.K, nt = K / BK;
    unsigned voffB[2], vAc[2][2], vAn[2][2]; int sR[2], sC[2];
    const size_t kstep = (size_t)(BK * 2);
    const size_t hstep = (size_t)HALF * K * 2;
    const size_t tstep = 2 * hstep;
#pragma unroll
    for (int i = 0; i < 2; ++i) { int R, C; stage_rc(tid * 16 + i * 8192, R, C); const int Rb = Epi::PERM ? ((R & ~31) + perm32(R & 31)) : R;
        sR[i] = R; sC[i] = C; voffB[i] = (unsigned)(Rb * K + C) * 2u;
        vAc[0][i] = (unsigned)(R * K + C) * 2u; vAc[1][i] = vAc[0][i] + (unsigned)hstep; vAn[0][i] = vAc[0][i]; vAn[1][i] = vAc[1][i]; }
    const unsigned ldsw = (unsigned)wid * 1024u;
    const int aoff = lds_byte(wr * 64 + fr, fq * 8), boff = lds_byte(wc * 32 + fr, fq * 8);
#define PG8_SA(b, h) (((b) * 2 + (h)) * HTB)
#define PG8_SB(b, h) ((4 + (b) * 2 + (h)) * HTB)
#define PG8_STAGE(bufoff, gbase, voff) do { _Pragma("unroll") for (int _i = 0; _i < 2; ++_i) \
        __builtin_amdgcn_global_load_lds((const unsigned*)((const char*)(gbase) + (voff)[_i]), (LAS unsigned*)(lds + (bufoff) + ldsw + _i * 8192), 16, 0, 0); } while (0)
#define PG8_LDA(dst, b, h) do { _Pragma("unroll") for (int m = 0; m < 4; ++m) _Pragma("unroll") for (int k = 0; k < 2; ++k) dst[m][k] = *(const LAS bf16x8*)(lds + PG8_SA(b, h) + aoff + m * 2048 + k * 1024); } while (0)
#define PG8_LDB(dst, b, h) do { _Pragma("unroll") for (int n = 0; n < 2; ++n) _Pragma("unroll") for (int k = 0; k < 2; ++k) dst[n][k] = *(const LAS bf16x8*)(lds + PG8_SB(b, h) + boff + n * 2048 + k * 1024); } while (0)
#define PG8_MMA(ai, bj, At, Bt) do { __builtin_amdgcn_s_setprio(1); _Pragma("unroll") for (int m = 0; m < 4; ++m) _Pragma("unroll") for (int n = 0; n < 2; ++n) _Pragma("unroll") for (int k = 0; k < 2; ++k) \
        acc[ai][bj][m][n] = __builtin_amdgcn_mfma_f32_16x16x32_bf16(Bt[n][k], At[m][k], acc[ai][bj][m][n], 0, 0, 0); __builtin_amdgcn_s_setprio(0); } while (0)
#define PG8_CAT(x0, x1) __builtin_shufflevector(__builtin_bit_cast(i32x4, x0), __builtin_bit_cast(i32x4, x1), 0, 1, 2, 3, 4, 5, 6, 7)
#define PG8_MMA8(ai, bj, At, Bt) do { __builtin_amdgcn_s_setprio(1); _Pragma("unroll") for (int m = 0; m < 4; ++m) _Pragma("unroll") for (int n = 0; n < 2; ++n) { \
        const i32x8 b8_ = PG8_CAT(Bt[n][0], Bt[n][1]), a8_ = PG8_CAT(At[m][0], At[m][1]); \
        asm volatile("v_mfma_scale_f32_16x16x128_f8f6f4 %0, %1, %2, %0, %3, %3 op_sel_hi:[0,0,0]" : "+v"(acc[ai][bj][m][n]) : "v"(b8_), "v"(a8_), "v"(sc1_)); } __builtin_amdgcn_s_setprio(0); } while (0)
#define PG8_MM(ai, bj, At, Bt) do { if constexpr (FP8) { PG8_MMA8(ai, bj, At, Bt); } else { PG8_MMA(ai, bj, At, Bt); } } while (0)
#define PG8_WAIT_V(n) asm volatile("s_waitcnt vmcnt(" #n ")" ::: "memory")
#define PG8_WAIT_L(n) asm volatile("s_waitcnt lgkmcnt(" #n ")" ::: "memory")
#define PG8_BAR __builtin_amdgcn_s_barrier()
#define PG8_SCHED __builtin_amdgcn_sched_barrier(0)
#define PG8_GATHER(dst, un) do { _Pragma("unroll") for (int _h = 0; _h < 2; ++_h) _Pragma("unroll") for (int _i = 0; _i < 2; ++_i) { \
        const int _lr = _h * HALF + sR[_i]; unsigned _p = 0u; if (_lr < (un).nvalid) _p = g.list[(un).lbase + _lr]; \
        dst[_h][_i] = ((_p >> 1) * (unsigned)K + (unsigned)sC[_i]) * 2u; asm volatile("" : "+v"(dst[_h][_i])); } } while (0)
    Unit cur, nxt; int ui = 0;
    if (!S.next(0, cur)) return;
    f32x4 acc[2][2][4][2];
#pragma unroll
    for (int a = 0; a < 2; ++a)
#pragma unroll
        for (int b = 0; b < 2; ++b)
#pragma unroll
            for (int m = 0; m < 4; ++m)
#pragma unroll
                for (int n = 0; n < 2; ++n) acc[a][b][m][n] = (f32x4){0.f, 0.f, 0.f, 0.f};
    bf16x8 At[4][2], B0[2][2], B1[2][2];
    const int sc1_ = 0x7f7f7f7f;
    const char* cA = GATHER ? (const char*)g.A : (const char*)g.A + (size_t)cur.pm * tstep; const char* cB = (const char*)g.Bt + (size_t)cur.pn * tstep;
    if constexpr (GATHER) { PG8_GATHER(vAc, cur); }
    PG8_STAGE(PG8_SB(0, 0), cB, voffB); PG8_STAGE(PG8_SB(0, 1), cB + hstep, voffB); PG8_STAGE(PG8_SA(0, 0), cA, vAc[0]); PG8_STAGE(PG8_SA(0, 1), cA, vAc[1]);
    if (wr == 1) PG8_BAR;
    PG8_WAIT_V(2); PG8_BAR;
    PG8_STAGE(PG8_SB(1, 0), cB + kstep, voffB); PG8_STAGE(PG8_SA(1, 0), cA + kstep, vAc[0]); PG8_STAGE(PG8_SB(1, 1), cB + hstep + kstep, voffB);
    PG8_WAIT_V(6); PG8_BAR;
    for (;;) {
        const bool has_next = S.next(ui + 1, nxt);
        const char* nA = has_next ? (GATHER ? (const char*)g.A : (const char*)g.A + (size_t)nxt.pm * tstep) : cA; const char* nB = has_next ? (const char*)g.Bt + (size_t)nxt.pn * tstep : cB;
        if constexpr (GATHER) {
            if (has_next) { PG8_GATHER(vAn, nxt); }
            else {
#pragma unroll
                for (int h = 0; h < 2; ++h)
#pragma unroll
                    for (int i = 0; i < 2; ++i) vAn[h][i] = vAc[h][i];
            }
        }
        _Pragma("nounroll") for (int t = 0; t < nt; t += 2) {
            const bool last = (t == nt - 2);
            const char* a1 = cA + (size_t)(t + 1) * kstep;
            const char* a2 = last ? nA : cA + (size_t)(t + 2) * kstep; const char* b2 = last ? nB : cB + (size_t)(t + 2) * kstep;
            const char* a3 = a2 + kstep; const char* b3 = b2 + kstep;
            unsigned vA2[2][2];
#pragma unroll
            for (int h = 0; h < 2; ++h)
#pragma unroll
                for (int i = 0; i < 2; ++i) vA2[h][i] = (GATHER && last) ? vAn[h][i] : vAc[h][i];
            PG8_LDB(B0, 0, 0); PG8_LDB(B1, 0, 1); PG8_SCHED; PG8_LDA(At, 0, 0); PG8_STAGE(PG8_SA(1, 1), a1, vAc[1]);
            PG8_WAIT_V(8); PG8_WAIT_L(0); PG8_BAR; PG8_MM(0, 0, At, B0); PG8_MM(0, 1, At, B1); PG8_BAR; PG8_SCHED;
            PG8_LDA(At, 0, 1); PG8_STAGE(PG8_SB(0, 0), b2, voffB); PG8_STAGE(PG8_SB(0, 1), b2 + hstep, voffB); PG8_STAGE(PG8_SA(0, 0), a2, vA2[0]);
            PG8_WAIT_V(8); PG8_WAIT_L(0); PG8_BAR; PG8_MM(1, 0, At, B0); PG8_MM(1, 1, At, B1); PG8_BAR; PG8_SCHED;
            PG8_LDB(B0, 1, 0); PG8_LDB(B1, 1, 1); PG8_SCHED; PG8_LDA(At, 1, 0); PG8_STAGE(PG8_SA(0, 1), a2, vA2[1]);
            PG8_WAIT_V(8); PG8_WAIT_L(0); PG8_BAR; PG8_MM(0, 0, At, B0); PG8_MM(0, 1, At, B1); PG8_BAR; PG8_SCHED;
            PG8_LDA(At, 1, 1); PG8_STAGE(PG8_SB(1, 0), b3, voffB); PG8_STAGE(PG8_SB(1, 1), b3 + hstep, voffB); PG8_STAGE(PG8_SA(1, 0), a3, vA2[0]);
            PG8_WAIT_V(8); PG8_WAIT_L(0); PG8_BAR; PG8_MM(1, 0, At, B0); PG8_MM(1, 1, At, B1); PG8_BAR; PG8_SCHED;
        }
        if (wr == 0) PG8_BAR;
        if constexpr (FP8) asm volatile("s_nop 15\n\ts_nop 7" ::: "memory");
        E(acc, cur, wr, wc, fr, fq);
        if (!has_next) break;
#pragma unroll
        for (int a = 0; a < 2; ++a)
#pragma unroll
            for (int b = 0; b < 2; ++b)
#pragma unroll
                for (int m = 0; m < 4; ++m)
#pragma unroll
                    for (int n = 0; n < 2; ++n) acc[a][b][m][n] = (f32x4){0.f, 0.f, 0.f, 0.f};
        cur = nxt; cA = nA; cB = nB; ++ui;
        if constexpr (GATHER) {
#pragma unroll
            for (int h = 0; h < 2; ++h)
#pragma unroll
                for (int i = 0; i < 2; ++i) vAc[h][i] = vAn[h][i];
        }
        if (wr == 1) PG8_BAR;
    }
    PG8_WAIT_V(0);
    PG8_BAR;
#undef PG8_SA
#undef PG8_SB
#undef PG8_STAGE
#undef PG8_LDA
#undef PG8_LDB
#undef PG8_MMA
#undef PG8_MMA8
#undef PG8_MM
#undef PG8_CAT
#undef PG8_WAIT_V
#undef PG8_WAIT_L
#undef PG8_BAR
#undef PG8_SCHED
#undef PG8_GATHER
}
}

typedef __attribute__((address_space(1))) unsigned gu32;
#define XB_TMO      128
#define XB_XCNT(j)  (256  + 64 * (j))
#define XB_XSUB(j)  (1280 + 64 * (j))
#define XB_XGEN(j)  (2304 + 64 * (j))
#define XB_TOP      3328
#define XB_TOPGEN   3392
#define XCD_BAR_WORDS 3456
#define XB_SPIN_CAP (1u << 18)
__device__ __forceinline__ unsigned xb_ld(unsigned* p)              { return __hip_atomic_load(p, __ATOMIC_RELAXED, __HIP_MEMORY_SCOPE_AGENT); }
__device__ __forceinline__ unsigned xb_add(unsigned* p, unsigned v) { return __hip_atomic_fetch_add(p, v, __ATOMIC_RELAXED, __HIP_MEMORY_SCOPE_AGENT); }
__device__ __forceinline__ unsigned xb_xcc_id() { return (unsigned)__builtin_amdgcn_s_getreg((3 << 11) | 20) & 0xFu; }
#define XB_SPIN(cond, bar) do { unsigned _sp = 0; while (cond) { __builtin_amdgcn_s_sleep(1); \
    if ((++_sp & 255u) == 0u) { if (xb_ld(&(bar)[XB_TMO])) break; if (_sp > XB_SPIN_CAP) { atomicAdd(&(bar)[XB_TMO], 1u); break; } } } } while (0)
struct XcdBarrier { unsigned* bar; unsigned x; volatile LAS unsigned* st; };
__device__ __forceinline__ XcdBarrier xcd_barrier_post(unsigned* bar, volatile LAS unsigned* st) {
    XcdBarrier b; b.bar = bar; b.x = xb_xcc_id(); b.st = st;
    if (threadIdx.x == 0) (void)xb_add(&bar[XB_XCNT(b.x)], 1u);
    return b;
}
__device__ __forceinline__ void xcd_barrier_complete(unsigned* bar, unsigned x, unsigned& nloc, unsigned& nx) {
    const unsigned G = gridDim.x * gridDim.y * gridDim.z;
    unsigned sum, cnt, mine, sp = 0u;
    for (;;) {
        sum = 0u; cnt = 0u; mine = 0u;
#pragma unroll
        for (unsigned j = 0; j < 16; ++j) { const unsigned c = xb_ld(&bar[XB_XCNT(j)]); sum += c; cnt += (c > 0u) ? 1u : 0u; mine = (j == x) ? c : mine; }
        if (sum == G) break;
        __builtin_amdgcn_s_sleep(1);
        if ((++sp & 255u) == 0u) { if (xb_ld(&bar[XB_TMO])) break; if (sp > XB_SPIN_CAP) { atomicAdd(&bar[XB_TMO], 1u); break; } }
    }
    nloc = mine > 0u ? mine : 1u; nx = cnt > 0u ? cnt : 1u;
}
__device__ __forceinline__ void xcd_barrier(const XcdBarrier& b) {
    asm volatile("s_waitcnt vmcnt(0)" ::: "memory");
    __syncthreads();
    if (threadIdx.x == 0) {
        unsigned* bar = b.bar;
        __builtin_amdgcn_s_waitcnt(0);
        unsigned nloc = b.st[0], nx = b.st[1];
        if (nloc == 0u) { xcd_barrier_complete(bar, b.x, nloc, nx); b.st[0] = nloc; b.st[1] = nx; }
        const unsigned old = xb_add(&bar[XB_XSUB(b.x)], 1u);
        const unsigned gen = old / nloc;
        if (old + 1u == (gen + 1u) * nloc) {
            __builtin_amdgcn_fence(__ATOMIC_RELEASE, "agent");
            asm volatile("s_waitcnt vmcnt(0)" ::: "memory");
            const unsigned og = xb_add(&bar[XB_TOP], 1u);
            const unsigned tg = og / nx;
            if (og + 1u == (tg + 1u) * nx) xb_add(&bar[XB_TOPGEN], 1u);
            else XB_SPIN(xb_ld(&bar[XB_TOPGEN]) == tg, bar);
            __builtin_amdgcn_fence(__ATOMIC_ACQUIRE, "agent");
            xb_add(&bar[XB_XGEN(b.x)], 1u);
            asm volatile("s_waitcnt vmcnt(0)" ::: "memory");
        } else {
            XB_SPIN(xb_ld(&bar[XB_XGEN(b.x)]) == gen, bar);
            __builtin_amdgcn_fence(__ATOMIC_ACQUIRE, "agent");
            asm volatile("s_waitcnt vmcnt(0)" ::: "memory");
        }
    }
    __syncthreads();
}

struct Args { const float* in[21]; float* out; unsigned char* ws; int ph_lo, ph_hi; };
struct Frame {
    LAS unsigned char* lds; int tid, lane, wave, G, blk;
    const float *x, *norm1_g, *w_in, *conv_qk, *b_igate, *b_fgate, *g_mlstm_out, *g_gmlp_v, *w_spatial, *b_spatial, *g_gmlp_out, *w_out, *norm2_g,
        *w_rg, *b_rg, *w_re, *b_re, *w_gate, *w_up, *w_down, *final_g;
    float* out; unsigned char* ws;
};

__device__ __forceinline__ void transpose_item64(const float* W, int ldw, int col0, int k0, bf16_t* dst, int K, const float* kscale, LAS unsigned* Tt, int lane) {
    const int kp = lane >> 4, nc = lane & 15;
    f32x4 a[8], b[8];
    const float* src = W + (size_t)(k0 + 2 * kp) * ldw + col0 + 4 * nc;
#pragma unroll
    for (int r = 0; r < 8; ++r) { a[r] = *(const f32x4*)(src + (size_t)(8 * r) * ldw); b[r] = *(const f32x4*)(src + (size_t)(8 * r + 1) * ldw); }
#pragma unroll
    for (int r = 0; r < 8; ++r) { float s0 = 1.f, s1 = 1.f; if (kscale) { s0 = kscale[k0 + 8 * r + 2 * kp]; s1 = kscale[k0 + 8 * r + 2 * kp + 1]; }
#pragma unroll
        for (int j = 0; j < 4; ++j) Tt[(4 * nc + j) * 32 + 4 * (r ^ (nc & 7)) + kp] = cvt_pk_bf16(a[r][j] * s0, b[r][j] * s1); }
    LDS_WAIT(); asm volatile("" ::: "memory");
#pragma unroll
    for (int i = 0; i < 8; ++i) { const int n = (lane >> 3) + 8 * i, c = lane & 7;
        const u32x4 v = *(const LAS u32x4*)(Tt + n * 32 + 4 * (c ^ ((n >> 2) & 7)));
        *(u32x4*)(dst + (size_t)n * K + k0 + 8 * c) = v; }
    LDS_WAIT(); asm volatile("" ::: "memory");
}
__device__ __forceinline__ void transpose_item64_fp8(const float* W, int ldw, int col0, int k0, unsigned char* dst, int K, const float* kscale, float wscale, LAS unsigned* Tt, int lane) {
    const int kp = lane >> 4, nc = lane & 15;
    f32x4 x[4][4];
    const float* src = W + (size_t)(k0 + 4 * kp) * ldw + col0 + 4 * nc;
#pragma unroll
    for (int r = 0; r < 4; ++r)
#pragma unroll
        for (int e = 0; e < 4; ++e) x[r][e] = *(const f32x4*)(src + (size_t)(16 * r + e) * ldw);
#pragma unroll
    for (int r = 0; r < 4; ++r) { float sc[4];
#pragma unroll
        for (int e = 0; e < 4; ++e) sc[e] = kscale ? kscale[k0 + 16 * r + 4 * kp + e] * wscale : wscale;
#pragma unroll
        for (int j = 0; j < 4; ++j) Tt[(4 * nc + j) * 20 + 4 * (r ^ ((nc >> 1) & 3)) + kp] = cvt4_fp8(x[r][0][j] * sc[0], x[r][1][j] * sc[1], x[r][2][j] * sc[2], x[r][3][j] * sc[3]); }
    LDS_WAIT(); asm volatile("" ::: "memory");
#pragma unroll
    for (int i = 0; i < 4; ++i) { const int n = (lane >> 2) + 16 * i, c = lane & 3;
        const u32x4 v = *(const LAS u32x4*)(Tt + n * 20 + 4 * (c ^ ((n >> 3) & 3)));
        *(u32x4*)(dst + (size_t)n * K + k0 + 16 * c) = v; }
    LDS_WAIT(); asm volatile("" ::: "memory");
}
__device__ __forceinline__ void p0_prologue(Frame& F) {
    LAS unsigned* scr = (LAS unsigned*)(F.lds + F.wave * 8192);
    const int gw = F.blk * NWAVES + F.wave, NGW = F.G * NWAVES;
    bf16_t* WIN = (bf16_t*)(F.ws + WS_WIN); bf16_t* WOUT = (bf16_t*)(F.ws + WS_WOUT); unsigned char* WGU = F.ws + WS_WGU; unsigned char* WD = F.ws + WS_WD;
    constexpr int I_IN = 16 * 48, I_OUT = 16 * 16, I_E = 384, NITEMS = I_IN + I_OUT + NE * I_E;
    for (int it = gw; it < NITEMS; it += NGW) {
        int r = it;
        if (r < I_IN) { const int kb = r / 48, nb = r % 48, n0 = 64 * nb; transpose_item64(F.w_in, DIN, n0 < 2048 ? n0 : n0 + 8, 64 * kb, WIN + (size_t)n0 * D, D, nullptr, scr, F.lane); continue; }
        r -= I_IN;
        if (r < I_OUT) { const int kb = r / 16, nb = r % 16; transpose_item64(F.w_out, D, 64 * nb, 64 * kb, WOUT + (size_t)(64 * nb) * D, D, nullptr, scr, F.lane); continue; }
        r -= I_OUT;
        const int e = r / I_E; r -= e * I_E;
        if (r < 256) { const bool up = r >= 128; r &= 127; const int kb = r / 8, nb = r % 8, j0 = 64 * nb;
            const float* W = (up ? F.w_up : F.w_gate) + (size_t)e * D * DFF;
            transpose_item64_fp8(W, DFF, j0, 64 * kb, WGU + ((size_t)e * 1024 + 256 * (j0 >> 7) + (up ? 128 : 0) + (j0 & 127)) * D, D, F.norm2_g, FP8_WSCALE, scr, F.lane); continue; }
        r -= 256;
        { const int kb = r / 16, nb = r % 16; transpose_item64_fp8(F.w_down + (size_t)e * DFF * D, D, 64 * nb, 64 * kb, WD + ((size_t)e * 1024 + 64 * nb) * DFF, DFF, nullptr, FP8_WSCALE, scr, F.lane); }
    }
    { const int gt = F.blk * 512 + F.tid, NT_ = F.G * 512; bf16_t* WR = (bf16_t*)(F.ws + WS_WR); bf16_t* WSP = (bf16_t*)(F.ws + WS_WSP);
        for (int i = gt; i < 48 * 1024; i += NT_) { const int n = i >> 10, k = i & 1023; float v = 0.f;
            if (n < 4) v = F.w_rg[k * 4 + n] * F.norm2_g[k]; else if (n < 36) v = F.w_re[k * 32 + (n - 4)] * F.norm2_g[k];
            WR[i] = (bf16_t)f2bf(v); }
        for (int i = gt; i < 8 * 128 * 128; i += NT_) { const int tt = (i >> 7) & 127, s = i & 127; WSP[i] = (bf16_t)f2bf(s <= tt ? F.w_spatial[i] : 0.f); } }
    {
        float wif[4][4][8];
#pragma unroll
        for (int j = 0; j < 4; ++j)
#pragma unroll
            for (int e = 0; e < 4; ++e) { const float* p = F.w_in + (size_t)(256 * j + 4 * F.lane + e) * DIN + 2048; const f32x4 a = *(const f32x4*)p, b = *(const f32x4*)(p + 4);
                wif[j][e][0] = a[0]; wif[j][e][1] = a[1]; wif[j][e][2] = a[2]; wif[j][e][3] = a[3]; wif[j][e][4] = b[0]; wif[j][e][5] = b[1]; wif[j][e][6] = b[2]; wif[j][e][7] = b[3]; }
        f32x4 g1[4];
#pragma unroll
        for (int j = 0; j < 4; ++j) g1[j] = *(const f32x4*)(F.norm1_g + 256 * j + 4 * F.lane);
        bf16_t* XN = (bf16_t*)(F.ws + WS_XN); float* IFP = (float*)(F.ws + WS_IFP);
        for (int m0 = gw; m0 < T; m0 += 2 * NGW) {
            f32x4 vv[2][4];
#pragma unroll
            for (int u = 0; u < 2; ++u) { const f32x4* xr = (const f32x4*)(F.x + (size_t)(m0 + u * NGW) * D) + F.lane;
#pragma unroll
                for (int j = 0; j < 4; ++j) vv[u][j] = xr[64 * j]; }
#pragma unroll
            for (int u = 0; u < 2; ++u) { const int m = m0 + u * NGW; f32x4 (&v)[4] = vv[u]; float s = 0.f;
#pragma unroll
                for (int j = 0; j < 4; ++j) s += (v[j][0] * v[j][0] + v[j][1] * v[j][1]) + (v[j][2] * v[j][2] + v[j][3] * v[j][3]);
                const float rstd = 1.0f / sqrtf(wave_sum(s) * (1.0f / D) + EPS);
                float dot[8];
#pragma unroll
                for (int n = 0; n < 8; ++n) dot[n] = 0.f;
                unsigned long long* o8 = (unsigned long long*)(XN + (size_t)m * D) + F.lane;
#pragma unroll
                for (int j = 0; j < 4; ++j) { v[j] = v[j] * rstd * g1[j];
#pragma unroll
                    for (int e = 0; e < 4; ++e)
#pragma unroll
                        for (int n = 0; n < 8; ++n) dot[n] += v[j][e] * wif[j][e][n];
                    o8[64 * j] = (unsigned long long)cvt_pk_bf16(v[j][0], v[j][1]) | ((unsigned long long)cvt_pk_bf16(v[j][2], v[j][3]) << 32); }
#pragma unroll
                for (int n = 0; n < 8; ++n) dot[n] = wave_sum(dot[n]);
                if (F.lane < 8) { float val = 0.f;
#pragma unroll
                    for (int n = 0; n < 8; ++n) if (F.lane == n) val = dot[n];
                    if (F.lane < 4) val += F.b_igate[F.lane];
                    else { const float f = val + F.b_fgate[F.lane - 4]; val = (f >= 0.f) ? -log1pf(expf(-f)) : (f - log1pf(expf(f))); }
                    IFP[(size_t)m * 8 + F.lane] = val; } }
        }
    }
}

#define BAR_LDS() do { asm volatile("s_waitcnt lgkmcnt(0)" ::: "memory"); __builtin_amdgcn_s_barrier(); asm volatile("" ::: "memory"); } while (0)
constexpr int TS64 = 144;
constexpr int TS128 = 272;
constexpr int CW_OFF = RING_BYTES + 2048;
__device__ __forceinline__ int sw64(int row, int chunk) { return row * TS64 + ((chunk ^ ((row >> 4) & 7)) << 4); }
__device__ __forceinline__ int sw128(int row, int chunk) { return row * TS128 + ((chunk ^ ((row >> 4) & 7)) << 4); }
__device__ __forceinline__ void conv2(const u32x4 (&x)[5], const LAS float* cwp, float scale, float (&o0)[8], float (&o1)[8]) {
    float xr[5][8];
#pragma unroll
    for (int i = 0; i < 5; ++i) unpack8(x[i], xr[i]);
    float cw[4][8];
#pragma unroll
    for (int i = 0; i < 4; ++i) { const f32x4 a = *(const LAS f32x4*)(cwp + i * 256), b = *(const LAS f32x4*)(cwp + i * 256 + 4);
        cw[i][0] = a[0]; cw[i][1] = a[1]; cw[i][2] = a[2]; cw[i][3] = a[3]; cw[i][4] = b[0]; cw[i][5] = b[1]; cw[i][6] = b[2]; cw[i][7] = b[3]; }
#pragma unroll
    for (int j = 0; j < 8; ++j) {
        const float y0 = cw[0][j] * xr[0][j] + cw[1][j] * xr[1][j] + cw[2][j] * xr[2][j] + cw[3][j] * xr[3][j];
        const float y1 = cw[0][j] * xr[1][j] + cw[1][j] * xr[2][j] + cw[2][j] * xr[3][j] + cw[3][j] * xr[4][j];
        o0[j] = silu_f(y0) * scale; o1[j] = silu_f(y1) * scale; }
}
__device__ __forceinline__ void load_conv_w(Frame& F, int h) {
    LAS float* CWL = (LAS float*)(F.lds + CW_OFF);
    for (int i = F.tid; i < 1024; i += 512) { const int tap = i >> 8, c = i & 255; CWL[i] = F.conv_qk[tap * 1024 + (c < 128 ? h * 128 + c : 512 + h * 128 + (c - 128))]; }
}
__device__ __forceinline__ u32x4 pack8(const float (&v)[8]) { u32x4 o; o.x = cvt_pk_bf16(v[0], v[1]); o.y = cvt_pk_bf16(v[2], v[3]); o.z = cvt_pk_bf16(v[4], v[5]); o.w = cvt_pk_bf16(v[6], v[7]); return o; }

struct P2aRegs { u32x4 k[5]; u32x4 v[2]; float ig, lf; };
__device__ __forceinline__ void p2a_load(Frame& F, int bh, int c, P2aRegs& R) {
    const bf16_t* PROJ = (const bf16_t*)(F.ws + WS_PROJ); const float* IFP = (const float*)(F.ws + WS_IFP);
    const int b = bh >> 2, h = bh & 3, trow0 = b * SEQ + c * 64, ch = F.tid & 15, g = F.tid >> 4;
    const int kcol = 512 + h * 128 + 8 * ch, vcol = 1024 + h * 128 + 8 * ch;
#pragma unroll
    for (int i = 0; i < 5; ++i) { const int r = 2 * g - 3 + i; R.k[i] = (u32x4){0u, 0u, 0u, 0u}; if (c * 64 + r >= 0) R.k[i] = *(const u32x4*)(PROJ + (size_t)(trow0 + r) * NPROJ + kcol); }
    R.v[0] = *(const u32x4*)(PROJ + (size_t)(trow0 + 2 * g) * NPROJ + vcol); R.v[1] = *(const u32x4*)(PROJ + (size_t)(trow0 + 2 * g + 1) * NPROJ + vcol);
    R.ig = 0.f; R.lf = 0.f;
    if (F.wave == 0) { const int t = trow0 + F.lane; R.ig = IFP[(size_t)t * 8 + h]; R.lf = IFP[(size_t)t * 8 + 4 + h]; }
}
__device__ __forceinline__ void p2a_compute(Frame& F, int bh, int c, const P2aRegs& R) {
    bf16_t* CST = (bf16_t*)(F.ws + WS_CST); float* NST = (float*)(F.ws + WS_NST); float* CHSC = (float*)(F.ws + WS_CHSC);
    LAS unsigned char* KT = F.lds; LAS unsigned char* VWT = F.lds + 18432; LAS float* WSV = (LAS float*)(F.lds + 36864);
    const LAS float* CWL = (const LAS float*)(F.lds + CW_OFF);
    const int tid = F.tid, lane = F.lane, ch = tid & 15, g = tid >> 4;
    BAR_LDS();
    if (F.wave == 0) {
        float bc = R.lf;
#pragma unroll
        for (int o = 1; o < 64; o <<= 1) { const float v = __shfl_up(bc, o); if (lane >= o) bc += v; }
        const float blast = __shfl(bc, 63);
        const float wst = blast - bc + R.ig;
        const float mloc = wave_max(wst);
        WSV[lane] = __expf(wst - mloc);
        if (lane == 0) { CHSC[(bh * 128 + c) * 2] = blast; CHSC[(bh * 128 + c) * 2 + 1] = mloc; }
    }
    {
        float k0[8], k1[8];
        conv2(R.k, CWL + 128 + 8 * ch, 0.08838834764831845f, k0, k1);
#pragma unroll
        for (int j = 0; j < 8; ++j) *(LAS unsigned*)(KT + sw64(8 * ch + j, g >> 2) + 4 * (g & 3)) = cvt_pk_bf16(k0[j], k1[j]);
    }
    BAR_LDS();
    {
        float v0[8], v1[8]; unpack8(R.v[0], v0); unpack8(R.v[1], v1);
        const float w0 = WSV[2 * g], w1 = WSV[2 * g + 1];
#pragma unroll
        for (int j = 0; j < 8; ++j) *(LAS unsigned*)(VWT + sw64(8 * ch + j, g >> 2) + 4 * (g & 3)) = cvt_pk_bf16(v0[j] * w0, v1[j] * w1);
    }
    BAR_LDS();
    {
        const int fr = lane & 15, fq = lane >> 4, w = F.wave;
        bf16x8 yv[2];
#pragma unroll
        for (int kk = 0; kk < 2; ++kk) yv[kk] = *(const LAS bf16x8*)(VWT + sw64(16 * w + fr, 4 * kk + fq));
        bf16_t* dst = CST + ((size_t)(bh * 128 + c) * 128 + 16 * w + fr) * 128;
#pragma unroll
        for (int dt = 0; dt < 8; ++dt) { f32x4 acc = (f32x4){0.f, 0.f, 0.f, 0.f};
#pragma unroll
            for (int kk = 0; kk < 2; ++kk) { const bf16x8 xk = *(const LAS bf16x8*)(KT + sw64(16 * dt + fr, 4 * kk + fq)); acc = MFMA16(xk, yv[kk], acc); }
            u32x2 o; o.x = cvt_pk_bf16(acc[0], acc[1]); o.y = cvt_pk_bf16(acc[2], acc[3]);
            *(u32x2*)(dst + 16 * dt + 4 * fq) = o; }
    }
    if (tid < 128) { float s = 0.f;
#pragma unroll
        for (int q8 = 0; q8 < 8; ++q8) { float kv[8]; unpack8(*(const LAS u32x4*)(KT + sw64(tid, q8)), kv);
#pragma unroll
            for (int j = 0; j < 8; ++j) s += kv[j] * WSV[q8 * 8 + j]; }
        NST[(size_t)(bh * 128 + c) * 128 + tid] = s; }
}
__device__ __forceinline__ void p2a_block(Frame& F) {
    const int bh = F.blk >> 4, c0 = (F.blk & 15) * 8;
    BAR_LDS(); load_conv_w(F, bh & 3);
    P2aRegs Ra; p2a_load(F, bh, c0, Ra);
#pragma unroll 1
    for (int i = 0; i < 8; ++i) { P2aRegs Rb = Ra; if (i < 7) p2a_load(F, bh, c0 + i + 1, Rb); p2a_compute(F, bh, c0 + i, Ra); Ra = Rb; }
}

struct GmRegs { u32x4 v[2]; u32x4 w[4]; u32x2 u[4]; f32x4 gv[2]; f32x4 go[4]; float bias; };
__device__ __forceinline__ void gm_load(Frame& F, int trow0, int g, GmRegs& R) {
    const bf16_t* PROJ = (const bf16_t*)(F.ws + WS_PROJ); const bf16_t* WSP = (const bf16_t*)(F.ws + WS_WSP);
    const int tid = F.tid, ch = tid & 7, rp = tid >> 3, col = 2560 + 64 * g + 8 * ch, fr = F.lane & 15, fq = F.lane >> 4, tt = 16 * F.wave + fr;
    R.v[0] = *(const u32x4*)(PROJ + (size_t)(trow0 + 2 * rp) * NPROJ + col); R.v[1] = *(const u32x4*)(PROJ + (size_t)(trow0 + 2 * rp + 1) * NPROJ + col);
#pragma unroll
    for (int i = 0; i < 4; ++i) { const int id = tid + 512 * i, row = id >> 4, c16 = id & 15; R.w[i] = *(const u32x4*)(WSP + (size_t)(g * 128 + row) * 128 + c16 * 8); }
#pragma unroll
    for (int ct = 0; ct < 4; ++ct) { R.u[ct] = *(const u32x2*)(PROJ + (size_t)(trow0 + tt) * NPROJ + 2048 + 64 * g + 16 * ct + 4 * fq); R.go[ct] = *(const f32x4*)(F.g_gmlp_out + 64 * g + 16 * ct + 4 * fq); }
    R.gv[0] = *(const f32x4*)(F.g_gmlp_v + 64 * g + 8 * ch); R.gv[1] = *(const f32x4*)(F.g_gmlp_v + 64 * g + 8 * ch + 4);
    R.bias = F.b_spatial[g * 128 + tt];
}
__device__ __forceinline__ void gmlp_tile(Frame& F, int tile) {
    const bf16_t* PROJ = (const bf16_t*)(F.ws + WS_PROJ); bf16_t* Y = (bf16_t*)(F.ws + WS_Y);
    LAS unsigned char* VBT = F.lds; LAS unsigned char* WS_ = F.lds + 17408; LAS float* RST = (LAS float*)(F.lds + 52224);
    const int trow0 = tile * 128, tid = F.tid, lane = F.lane, w = F.wave, fr = lane & 15, fq = lane >> 4;
    GmRegs Ra; gm_load(F, trow0, 0, Ra);
    BAR_LDS();
    {
        u32x4 rr[16];
#pragma unroll
        for (int r = 0; r < 16; ++r) rr[r] = *(const u32x4*)(PROJ + (size_t)(trow0 + w * 16 + r) * NPROJ + 2560 + 8 * lane);
#pragma unroll
        for (int r = 0; r < 16; ++r) { float v[8]; unpack8(rr[r], v); float s = 0.f;
#pragma unroll
            for (int j = 0; j < 8; ++j) s += v[j] * v[j];
            s = wave_sum(s); if (lane == 0) RST[w * 16 + r] = 1.0f / sqrtf(s * (1.0f / 512.0f) + EPS); }
    }
#pragma unroll 1
    for (int g = 0; g < 8; ++g) {
        GmRegs Rb = Ra; if (g < 7) gm_load(F, trow0, g + 1, Rb);
        BAR_LDS();
        {
            const int ch = tid & 7, rp = tid >> 3;
            float v0[8], v1[8]; unpack8(Ra.v[0], v0); unpack8(Ra.v[1], v1);
            const float r0 = RST[2 * rp], r1 = RST[2 * rp + 1];
            const float gg[8] = {Ra.gv[0][0], Ra.gv[0][1], Ra.gv[0][2], Ra.gv[0][3], Ra.gv[1][0], Ra.gv[1][1], Ra.gv[1][2], Ra.gv[1][3]};
#pragma unroll
            for (int j = 0; j < 8; ++j) *(LAS unsigned*)(VBT + sw128(8 * ch + j, rp >> 2) + 4 * (rp & 3)) = cvt_pk_bf16(v0[j] * r0 * gg[j], v1[j] * r1 * gg[j]);
#pragma unroll
            for (int i = 0; i < 4; ++i) { const int id = tid + 512 * i, row = id >> 4, c16 = id & 15; *(LAS u32x4*)(WS_ + row * TS128 + c16 * 16) = Ra.w[i]; }
        }
        BAR_LDS();
        f32x4 acc[4];
#pragma unroll
        for (int ct = 0; ct < 4; ++ct) acc[ct] = (f32x4){0.f, 0.f, 0.f, 0.f};
#pragma unroll
        for (int kk = 0; kk < 4; ++kk) if (32 * kk <= 16 * w + 15) { const bf16x8 yw = *(const LAS bf16x8*)(WS_ + (16 * w + fr) * TS128 + (32 * kk + 8 * fq) * 2);
#pragma unroll
            for (int ct = 0; ct < 4; ++ct) { const bf16x8 xv = *(const LAS bf16x8*)(VBT + sw128(16 * ct + fr, 4 * kk + fq)); acc[ct] = MFMA16(xv, yw, acc[ct]); } }
        const int trow = trow0 + 16 * w + fr;
        float gvv[4][4]; float ss = 0.f;
#pragma unroll
        for (int ct = 0; ct < 4; ++ct) { const float uu[4] = {bflo(Ra.u[ct].x), bfhi(Ra.u[ct].x), bflo(Ra.u[ct].y), bfhi(Ra.u[ct].y)};
#pragma unroll
            for (int j = 0; j < 4; ++j) { gvv[ct][j] = uu[j] * (acc[ct][j] + Ra.bias); ss += gvv[ct][j] * gvv[ct][j]; } }
        ss += __shfl_xor(ss, 16); ss += __shfl_xor(ss, 32);
        const float rs = 1.0f / sqrtf(ss * (1.0f / 64.0f) + EPS);
#pragma unroll
        for (int ct = 0; ct < 4; ++ct) { u32x2 o; o.x = cvt_pk_bf16(gvv[ct][0] * rs * Ra.go[ct][0], gvv[ct][1] * rs * Ra.go[ct][1]); o.y = cvt_pk_bf16(gvv[ct][2] * rs * Ra.go[ct][2], gvv[ct][3] * rs * Ra.go[ct][3]);
            *(u32x2*)(Y + (size_t)trow * D + 512 + 64 * g + 16 * ct + 4 * fq) = o; }
        Ra = Rb;
    }
}

__device__ __forceinline__ void scan_phase(Frame& F) {
    const float* CHSC = (const float*)(F.ws + WS_CHSC); float* MST = (float*)(F.ws + WS_MST); float* NST = (float*)(F.ws + WS_NST);
    unsigned* CST = (unsigned*)(F.ws + WS_CST);
    LAS float* SA = (LAS float*)F.lds; LAS float* SB = SA + 128; LAS float* SCB = SB + 128;
    LAS float* NL = (LAS float*)(F.lds + 4096);
    const int bh = F.blk >> 4, sub = F.blk & 15, tid = F.tid;
    BAR_LDS();
    if (tid < 256) SCB[tid] = CHSC[bh * 256 + tid];
    unsigned* p = CST + (size_t)bh * 128 * 8192 + sub * 512 + tid;
    unsigned ka[16], kb[16];
#pragma unroll
    for (int i = 0; i < 16; ++i) ka[i] = p[(size_t)i * 8192];
    if (sub == 0) {
#pragma unroll
        for (int i = 0; i < 8; ++i) { const int id = tid + 512 * i; *(LAS f32x4*)(NL + id * 4) = *(const f32x4*)(NST + (size_t)bh * 16384 + id * 4); }
    }
    BAR_LDS();
    if (tid == 0) { float m = 0.f;
        for (int c = 0; c < 128; ++c) { const float blast = SCB[2 * c], mloc = SCB[2 * c + 1]; const float mn = fmaxf(blast + m, mloc);
            SA[c] = __expf(blast + m - mn); SB[c] = __expf(mloc - mn); if (sub == 0) MST[bh * 128 + c] = m; m = mn; } }
    BAR_LDS();
    float s0 = 0.f, s1 = 0.f;
#pragma unroll 1
    for (int c0 = 0; c0 < 128; c0 += 32) {
#pragma unroll
        for (int i = 0; i < 16; ++i) kb[i] = p[(size_t)(c0 + 16 + i) * 8192];
#pragma unroll
        for (int i = 0; i < 16; ++i) { p[(size_t)(c0 + i) * 8192] = cvt_pk_bf16(s0, s1); const float a = SA[c0 + i], b = SB[c0 + i]; s0 = a * s0 + b * bflo(ka[i]); s1 = a * s1 + b * bfhi(ka[i]); }
        if (c0 + 32 < 128) {
#pragma unroll
            for (int i = 0; i < 16; ++i) ka[i] = p[(size_t)(c0 + 32 + i) * 8192];
        }
#pragma unroll
        for (int i = 0; i < 16; ++i) { p[(size_t)(c0 + 16 + i) * 8192] = cvt_pk_bf16(s0, s1); const float a = SA[c0 + 16 + i], b = SB[c0 + 16 + i]; s0 = a * s0 + b * bflo(kb[i]); s1 = a * s1 + b * bfhi(kb[i]); }
    }
    if (sub == 0) {
        if (tid < 128) { float s = 0.f;
            for (int c = 0; c < 128; ++c) { const float nl = NL[c * 128 + tid]; NL[c * 128 + tid] = s; s = SA[c] * s + SB[c] * nl; } }
        BAR_LDS();
#pragma unroll
        for (int i = 0; i < 8; ++i) { const int id = tid + 512 * i; *(f32x4*)(NST + (size_t)bh * 16384 + id * 4) = *(const LAS f32x4*)(NL + id * 4); }
    }
    BAR_LDS();
}

struct P4Regs { u32x4 q[5], k[5], v[2], o[2], cs[4]; float ig, lf, mc, n0, n1; };
__device__ __forceinline__ void p4_load(Frame& F, int bh, int c, P4Regs& R) {
    const bf16_t* PROJ = (const bf16_t*)(F.ws + WS_PROJ); const float* IFP = (const float*)(F.ws + WS_IFP);
    const bf16_t* CST = (const bf16_t*)(F.ws + WS_CST); const float* NST = (const float*)(F.ws + WS_NST); const float* MST = (const float*)(F.ws + WS_MST);
    const int b = bh >> 2, h = bh & 3, trow0 = b * SEQ + c * 64, tid = F.tid, ch = tid & 15, g = tid >> 4;
    const int qcol = h * 128 + 8 * ch, kcol = 512 + qcol, vcol = 1024 + qcol;
#pragma unroll
    for (int i = 0; i < 5; ++i) { const int r = 2 * g - 3 + i; R.q[i] = (u32x4){0u, 0u, 0u, 0u}; R.k[i] = (u32x4){0u, 0u, 0u, 0u};
        if (c * 64 + r >= 0) { R.q[i] = *(const u32x4*)(PROJ + (size_t)(trow0 + r) * NPROJ + qcol); R.k[i] = *(const u32x4*)(PROJ + (size_t)(trow0 + r) * NPROJ + kcol); } }
    R.v[0] = *(const u32x4*)(PROJ + (size_t)(trow0 + 2 * g) * NPROJ + vcol); R.v[1] = *(const u32x4*)(PROJ + (size_t)(trow0 + 2 * g + 1) * NPROJ + vcol);
    { const int l = tid >> 3, seg = tid & 7; const bf16_t* op = PROJ + (size_t)(trow0 + l) * NPROJ + 1536 + h * 128 + 16 * seg; R.o[0] = *(const u32x4*)op; R.o[1] = *(const u32x4*)(op + 8); }
    { const bf16_t* src = CST + (size_t)(bh * 128 + c) * 16384;
#pragma unroll
      for (int i = 0; i < 4; ++i) { const int id = tid + 512 * i, row = id >> 4, c16 = id & 15; R.cs[i] = *(const u32x4*)(src + row * 128 + c16 * 8); } }
    R.n0 = 0.f; R.n1 = 0.f; R.ig = 0.f; R.lf = 0.f; R.mc = 0.f;
    if (tid < 64) { const float* ns = NST + (size_t)(bh * 128 + c) * 128 + 2 * tid; R.n0 = ns[0]; R.n1 = ns[1];
        const int t = trow0 + tid; R.ig = IFP[(size_t)t * 8 + h]; R.lf = IFP[(size_t)t * 8 + 4 + h]; R.mc = MST[bh * 128 + c]; }
}
__device__ __forceinline__ void p4_block(Frame& F) {
    bf16_t* Y = (bf16_t*)(F.ws + WS_Y);
    LAS unsigned char* Q = F.lds; LAS unsigned char* QW = F.lds + 17408; LAS unsigned char* KK = F.lds + 34816; LAS unsigned char* VT = F.lds + 52224;
    LAS unsigned char* CS = F.lds + 72960; LAS unsigned char* P = F.lds + 112128; LAS float* SC = (LAS float*)(F.lds + 121344); LAS float* HBUF = (LAS float*)F.lds;
    LAS float* S_BC = SC, * S_A = SC + 64, * S_MT = SC + 128, * S_WI = SC + 192, * S_EN = SC + 256, * S_NQ = SC + 320;
    const LAS float* CWL = (const LAS float*)(F.lds + CW_OFF);
    const int bh = F.blk >> 4, c0 = (F.blk & 15) * 8, b = bh >> 2, h = bh & 3;
    const int tid = F.tid, lane = F.lane, w = F.wave, fr = lane & 15, fq = lane >> 4, ch = tid & 15, g = tid >> 4;
    BAR_LDS(); load_conv_w(F, h);
    float gm[16];
    { const int seg = tid & 7;
#pragma unroll
      for (int j4 = 0; j4 < 4; ++j4) { const f32x4 t4 = *(const f32x4*)(F.g_mlstm_out + h * 128 + 16 * seg + 4 * j4); gm[4 * j4] = t4[0]; gm[4 * j4 + 1] = t4[1]; gm[4 * j4 + 2] = t4[2]; gm[4 * j4 + 3] = t4[3]; } }
    P4Regs R; p4_load(F, bh, c0, R);
#pragma unroll 1
    for (int ci = 0; ci < 8; ++ci) {
        const int c = c0 + ci, trow0 = b * SEQ + c * 64;
        BAR_LDS();
        if (w == 0) {
            float bc = R.lf;
#pragma unroll
            for (int o = 1; o < 64; o <<= 1) { const float v = __shfl_up(bc, o); if (lane >= o) bc += v; }
            const float a = R.ig - bc; float pm = a;
#pragma unroll
            for (int o = 1; o < 64; o <<= 1) { const float v = __shfl_up(pm, o); if (lane >= o) pm = fmaxf(pm, v); }
            const float inter = bc + R.mc, mt = fmaxf(inter, bc + pm);
            S_BC[lane] = bc; S_A[lane] = a; S_MT[lane] = mt; S_WI[lane] = __expf(inter - mt); S_EN[lane] = __expf(-mt);
        }
        float q0[8], q1[8];
        conv2(R.q, CWL + 8 * ch, 1.0f, q0, q1);
        {
            float k0[8], k1[8];
            conv2(R.k, CWL + 128 + 8 * ch, 0.08838834764831845f, k0, k1);
            *(LAS u32x4*)(KK + (2 * g) * TS128 + 16 * ch) = pack8(k0); *(LAS u32x4*)(KK + (2 * g + 1) * TS128 + 16 * ch) = pack8(k1);
            *(LAS u32x4*)(Q + (2 * g) * TS128 + 16 * ch) = pack8(q0); *(LAS u32x4*)(Q + (2 * g + 1) * TS128 + 16 * ch) = pack8(q1);
        }
        {
            float v0[8], v1[8]; unpack8(R.v[0], v0); unpack8(R.v[1], v1);
#pragma unroll
            for (int j = 0; j < 8; ++j) *(LAS unsigned*)(VT + sw64(8 * ch + j, g >> 2) + 4 * (g & 3)) = cvt_pk_bf16(v0[j], v1[j]);
            *(LAS unsigned*)(VT + (128 + (tid >> 5)) * TS64 + 4 * (tid & 31)) = (tid < 32) ? 0x3F803F80u : 0u;
        }
        {
#pragma unroll
            for (int i = 0; i < 4; ++i) { const int id = tid + 512 * i, row = id >> 4, c16 = id & 15; *(LAS u32x4*)(CS + row * TS128 + c16 * 16) = R.cs[i]; }
            if (tid < 64) *(LAS unsigned*)(CS + 128 * TS128 + 4 * tid) = cvt_pk_bf16(R.n0, R.n1);
            else if (tid < 64 + 240) { const int id = tid - 64, row = 129 + (id >> 4), c16 = id & 15; *(LAS u32x4*)(CS + row * TS128 + c16 * 16) = (u32x4){0u, 0u, 0u, 0u}; }
        }
        const u32x4 oa = R.o[0], ob = R.o[1];
        if (ci < 7) p4_load(F, bh, c + 1, R);
        BAR_LDS();
        {
            const float w0 = S_WI[2 * g], w1 = S_WI[2 * g + 1];
#pragma unroll
            for (int j = 0; j < 8; ++j) { q0[j] *= w0; q1[j] *= w1; }
            *(LAS u32x4*)(QW + (2 * g) * TS128 + 16 * ch) = pack8(q0); *(LAS u32x4*)(QW + (2 * g + 1) * TS128 + 16 * ch) = pack8(q1);
        }
        {
            const int lt = w >> 1; const int l = 16 * lt + fr; const float bl = S_BC[l], ml = S_MT[l];
#pragma unroll
            for (int si = 0; si < 2; ++si) { const int st = 2 * (w & 1) + si; f32x4 acc = (f32x4){0.f, 0.f, 0.f, 0.f};
                if (st <= lt) {
#pragma unroll
                    for (int kk = 0; kk < 4; ++kk) { const bf16x8 xk = *(const LAS bf16x8*)(KK + (16 * st + fr) * TS128 + (32 * kk + 8 * fq) * 2); const bf16x8 yq = *(const LAS bf16x8*)(Q + l * TS128 + (32 * kk + 8 * fq) * 2); acc = MFMA16(xk, yq, acc); }
                }
                float pv[4];
#pragma unroll
                for (int j = 0; j < 4; ++j) { const int s = 16 * st + 4 * fq + j; pv[j] = (s <= l) ? acc[j] * __expf(bl + S_A[s] - ml) : 0.f; }
                u32x2 o; o.x = cvt_pk_bf16(pv[0], pv[1]); o.y = cvt_pk_bf16(pv[2], pv[3]);
                *(LAS u32x2*)(P + l * TS64 + (16 * st + 4 * fq) * 2) = o; }
        }
        BAR_LDS();
        f32x4 acc[4], accx = (f32x4){0.f, 0.f, 0.f, 0.f};
#pragma unroll
        for (int lt = 0; lt < 4; ++lt) { acc[lt] = (f32x4){0.f, 0.f, 0.f, 0.f};
#pragma unroll
            for (int kk = 0; kk < 2; ++kk) { const bf16x8 xv = *(const LAS bf16x8*)(VT + sw64(16 * w + fr, 4 * kk + fq)); const bf16x8 yp = *(const LAS bf16x8*)(P + (16 * lt + fr) * TS64 + (32 * kk + 8 * fq) * 2); acc[lt] = MFMA16(xv, yp, acc[lt]); }
#pragma unroll
            for (int kk = 0; kk < 4; ++kk) { const bf16x8 xc = *(const LAS bf16x8*)(CS + (16 * w + fr) * TS128 + (32 * kk + 8 * fq) * 2); const bf16x8 yq = *(const LAS bf16x8*)(QW + (16 * lt + fr) * TS128 + (32 * kk + 8 * fq) * 2); acc[lt] = MFMA16(xc, yq, acc[lt]); } }
        if (w < 4) {
#pragma unroll
            for (int kk = 0; kk < 2; ++kk) { const bf16x8 xv = *(const LAS bf16x8*)(VT + (128 + fr) * TS64 + (32 * kk + 8 * fq) * 2); const bf16x8 yp = *(const LAS bf16x8*)(P + (16 * w + fr) * TS64 + (32 * kk + 8 * fq) * 2); accx = MFMA16(xv, yp, accx); }
#pragma unroll
            for (int kk = 0; kk < 4; ++kk) { const bf16x8 xc = *(const LAS bf16x8*)(CS + (128 + fr) * TS128 + (32 * kk + 8 * fq) * 2); const bf16x8 yq = *(const LAS bf16x8*)(QW + (16 * w + fr) * TS128 + (32 * kk + 8 * fq) * 2); accx = MFMA16(xc, yq, accx); }
            if (fq == 0) S_NQ[16 * w + fr] = accx[0];
        }
        BAR_LDS();
#pragma unroll
        for (int lt = 0; lt < 4; ++lt) *(LAS f32x4*)(HBUF + (16 * lt + fr) * 132 + 16 * w + 4 * fq) = acc[lt];
        BAR_LDS();
        {
            const int l = tid >> 3, seg = tid & 7, t = trow0 + l;
            const float den = 1.0f / fmaxf(fabsf(S_NQ[l]), S_EN[l]);
            float ov[16]; { float t8[8]; unpack8(oa, t8);
#pragma unroll
                for (int j = 0; j < 8; ++j) ov[j] = t8[j];
                unpack8(ob, t8);
#pragma unroll
                for (int j = 0; j < 8; ++j) ov[8 + j] = t8[j]; }
            float hv[16]; float ss = 0.f;
#pragma unroll
            for (int j4 = 0; j4 < 4; ++j4) { const f32x4 nv = *(const LAS f32x4*)(HBUF + l * 132 + 16 * seg + 4 * j4);
#pragma unroll
                for (int j = 0; j < 4; ++j) { const float x = nv[j] * den * ov[4 * j4 + j]; hv[4 * j4 + j] = x; ss += x * x; } }
            ss += __shfl_xor(ss, 1); ss += __shfl_xor(ss, 2); ss += __shfl_xor(ss, 4);
            const float rs = 1.0f / sqrtf(ss * (1.0f / 128.0f) + EPS);
#pragma unroll
            for (int j = 0; j < 16; ++j) hv[j] *= rs * gm[j];
            u32x4 o; o.x = cvt_pk_bf16(hv[0], hv[1]); o.y = cvt_pk_bf16(hv[2], hv[3]); o.z = cvt_pk_bf16(hv[4], hv[5]); o.w = cvt_pk_bf16(hv[6], hv[7]);
            *(u32x4*)(Y + (size_t)t * D + h * 128 + 16 * seg) = o;
            o.x = cvt_pk_bf16(hv[8], hv[9]); o.y = cvt_pk_bf16(hv[10], hv[11]); o.z = cvt_pk_bf16(hv[12], hv[13]); o.w = cvt_pk_bf16(hv[14], hv[15]);
            *(u32x4*)(Y + (size_t)t * D + h * 128 + 16 * seg + 8) = o;
        }
    }
    BAR_LDS();
}

constexpr int WR_STR = 2064;
__device__ __forceinline__ void router_phase(Frame& F) {
    const bf16_t* HB = (const bf16_t*)(F.ws + WS_HB); const bf16_t* WR = (const bf16_t*)(F.ws + WS_WR); const float* HSQ = (const float*)(F.ws + WS_HSQ);
    unsigned* LIST = (unsigned*)(F.ws + WS_LIST); float* SRSTD = (float*)(F.ws + WS_SRSTD); float* SW = (float*)(F.ws + WS_SW); unsigned* GCNT = (unsigned*)(F.ws + WS_CTL) + CW_GCNT;
    LAS unsigned char* WRL = F.lds; LAS float* LOG = (LAS float*)(F.lds + 99072); LAS unsigned* CNT = (LAS unsigned*)(F.lds + 99072 + 26624); LAS unsigned* BASE = CNT + 32;
    const int tid = F.tid, lane = F.lane, w = F.wave, fr = lane & 15, fq = lane >> 4;
    for (int tb = F.blk; tb < T / 128; tb += F.G) {
        __syncthreads();
#pragma unroll
        for (int i = 0; i < 12; ++i) { const int id = tid + 512 * i, row = id >> 7, c16 = id & 127; *(LAS u32x4*)(WRL + row * WR_STR + c16 * 16) = *(const u32x4*)(WR + (size_t)row * 1024 + c16 * 8); }
        if (tid < 32) CNT[tid] = 0u;
        __syncthreads();
        const int t0 = tb * 128 + w * 16;
        f32x4 acc[3];
#pragma unroll
        for (int nt = 0; nt < 3; ++nt) acc[nt] = (f32x4){0.f, 0.f, 0.f, 0.f};
        const bf16_t* hrow = HB + (size_t)(t0 + fr) * D + 8 * fq;
#pragma unroll 8
        for (int kk = 0; kk < 32; ++kk) { const bf16x8 y = *(const bf16x8*)(hrow + 32 * kk);
#pragma unroll
            for (int nt = 0; nt < 3; ++nt) { const bf16x8 x = *(const LAS bf16x8*)(WRL + (16 * nt + fr) * WR_STR + (32 * kk + 8 * fq) * 2); acc[nt] = MFMA16(x, y, acc[nt]); } }
        LAS float* lg = LOG + w * (16 * 52);
#pragma unroll
        for (int nt = 0; nt < 3; ++nt) *(LAS f32x4*)(lg + fr * 52 + 16 * nt + 4 * fq) = acc[nt];
        __syncthreads();
        int e0 = 0, e1 = 0; unsigned r0 = 0, r1 = 0; float w0 = 0.f, w1 = 0.f, rstd = 0.f; const int t = t0 + lane;
        if (lane < 16) {
            float ss = 0.f;
#pragma unroll
            for (int i = 0; i < 4; ++i) { const f32x4 v = *(const f32x4*)(HSQ + (size_t)t * 16 + 4 * i); ss += (v[0] + v[1]) + (v[2] + v[3]); }
            rstd = 1.0f / sqrtf(ss * (1.0f / D) + EPS);
            const LAS float* L = lg + lane * 52;
            float gl[4]; int gs = 0; float gmx;
#pragma unroll
            for (int i = 0; i < 4; ++i) gl[i] = L[i] * rstd + F.b_rg[i];
            gmx = gl[0];
#pragma unroll
            for (int i = 1; i < 4; ++i) if (gl[i] > gmx) { gmx = gl[i]; gs = i; }
            float gsum = 0.f;
#pragma unroll
            for (int i = 0; i < 4; ++i) gsum += __expf(gl[i] - gmx);
            const float pg = 1.0f / gsum;
            float el[8];
#pragma unroll
            for (int i = 0; i < 8; ++i) el[i] = L[4 + gs * 8 + i] * rstd + F.b_re[gs * 8 + i];
            int i0 = 0; float m0 = el[0];
#pragma unroll
            for (int i = 1; i < 8; ++i) if (el[i] > m0) { m0 = el[i]; i0 = i; }
            int i1 = (i0 == 0) ? 1 : 0; float m1 = (i0 == 0) ? el[1] : el[0];
#pragma unroll
            for (int i = 1; i < 8; ++i) if (i != i0 && el[i] > m1) { m1 = el[i]; i1 = i; }
            const float ex = __expf(m1 - m0);
            w0 = pg / (1.0f + ex); w1 = pg * ex / (1.0f + ex);
            e0 = gs * 8 + i0; e1 = gs * 8 + i1;
            r0 = atomicAdd((unsigned*)&CNT[e0], 1u); r1 = atomicAdd((unsigned*)&CNT[e1], 1u);
        }
        __syncthreads();
        if (tid < 32) BASE[tid] = __hip_atomic_fetch_add(GCNT + tid, CNT[tid], __ATOMIC_RELAXED, __HIP_MEMORY_SCOPE_AGENT);
        __syncthreads();
        if (lane < 16) {
            const unsigned i0 = (unsigned)e0 * CAP + BASE[e0] + r0, i1 = (unsigned)e1 * CAP + BASE[e1] + r1;
            LIST[i0] = 2u * t; SRSTD[i0] = rstd; SW[i0] = w0;
            LIST[i1] = 2u * t + 1u; SRSTD[i1] = rstd; SW[i1] = w1;
        }
    }
}

__device__ __forceinline__ void final_phase(Frame& F) {
    const bf16_t* HB = (const bf16_t*)(F.ws + WS_HB); const bf16_t* YE = (const bf16_t*)(F.ws + WS_YE);
    const int gw = F.blk * NWAVES + F.wave, NGW = F.G * NWAVES, lane = F.lane;
    f32x4 fg[4];
#pragma unroll
    for (int i = 0; i < 4; ++i) fg[i] = *(const f32x4*)(F.final_g + 16 * lane + 4 * i);
    for (int m0 = gw; m0 < T; m0 += 2 * NGW) {
        u32x4 ra[2][2], rb[2][2], rc[2][2];
#pragma unroll
        for (int u = 0; u < 2; ++u) { const int m = m0 + u * NGW;
#pragma unroll
            for (int hh = 0; hh < 2; ++hh) { ra[u][hh] = *(const u32x4*)(HB + (size_t)m * D + 16 * lane + 8 * hh); rb[u][hh] = *(const u32x4*)(YE + (size_t)(2 * m) * D + 16 * lane + 8 * hh); rc[u][hh] = *(const u32x4*)(YE + (size_t)(2 * m + 1) * D + 16 * lane + 8 * hh); } }
#pragma unroll
        for (int u = 0; u < 2; ++u) { const int m = m0 + u * NGW; float v[16]; float s = 0.f;
#pragma unroll
            for (int hh = 0; hh < 2; ++hh) { float a[8], b[8], c[8]; unpack8(ra[u][hh], a); unpack8(rb[u][hh], b); unpack8(rc[u][hh], c);
#pragma unroll
                for (int j = 0; j < 8; ++j) { const float x = a[j] + b[j] + c[j]; v[8 * hh + j] = x; s += x * x; } }
            const float rstd = 1.0f / sqrtf(wave_sum(s) * (1.0f / D) + EPS);
            float* o = F.out + (size_t)m * D + 16 * lane;
#pragma unroll
            for (int i = 0; i < 4; ++i) { f32x4 r; r[0] = v[4 * i] * rstd * fg[i][0]; r[1] = v[4 * i + 1] * rstd * fg[i][1]; r[2] = v[4 * i + 2] * rstd * fg[i][2]; r[3] = v[4 * i + 3] * rstd * fg[i][3]; *(f32x4*)(o + 4 * i) = r; } }
    }
}

#ifndef MK_DBG_TELE
#define MK_DBG_TELE 0
#endif
constexpr int CW_TELE = 128;
__device__ __forceinline__ void dbg_count_bf16(Frame& F, const bf16_t* p, size_t n, int slot) {
    unsigned bad = 0; const size_t gt = (size_t)F.blk * 512 + F.tid, NT_ = (size_t)F.G * 512;
    for (size_t i = gt; i < n; i += NT_) { const float v = bflo((unsigned)p[i]); if (!(fabsf(v) < 1.0e6f)) ++bad; }
    if (bad) atomicAdd((unsigned*)(F.ws + WS_CTL) + CW_TELE + slot, bad);
}
__device__ __forceinline__ void dbg_count_f32(Frame& F, const float* p, size_t n, int slot) {
    unsigned bad = 0; const size_t gt = (size_t)F.blk * 512 + F.tid, NT_ = (size_t)F.G * 512;
    for (size_t i = gt; i < n; i += NT_) { const float v = p[i]; if (!(fabsf(v) < 1.0e6f)) ++bad; }
    if (bad) atomicAdd((unsigned*)(F.ws + WS_CTL) + CW_TELE + slot, bad);
}
__device__ __forceinline__ void dbg_check_phase(Frame& F, int p) {
    if (p == 0) { dbg_count_bf16(F, (const bf16_t*)(F.ws + WS_XN), (size_t)T * D, 1); dbg_count_f32(F, (const float*)(F.ws + WS_IFP), (size_t)T * 8, 2); dbg_count_bf16(F, (const bf16_t*)(F.ws + WS_WIN), (size_t)NPROJ * D, 3);
                  dbg_count_bf16(F, (const bf16_t*)(F.ws + WS_WGU), (size_t)NE * 1024 * D, 4); dbg_count_bf16(F, (const bf16_t*)(F.ws + WS_WD), (size_t)NE * 1024 * DFF, 5); dbg_count_bf16(F, (const bf16_t*)(F.ws + WS_WOUT), (size_t)D * D, 6); }
    if (p == 1) dbg_count_bf16(F, (const bf16_t*)(F.ws + WS_PROJ), (size_t)T * NPROJ, 7);
    if (p == 2) { dbg_count_bf16(F, (const bf16_t*)(F.ws + WS_CST), (size_t)2048 * 16384, 8); dbg_count_f32(F, (const float*)(F.ws + WS_NST), (size_t)2048 * 128, 9); dbg_count_f32(F, (const float*)(F.ws + WS_CHSC), (size_t)4096, 10); }
    if (p == 3) { dbg_count_bf16(F, (const bf16_t*)(F.ws + WS_CST), (size_t)2048 * 16384, 11); dbg_count_f32(F, (const float*)(F.ws + WS_NST), (size_t)2048 * 128, 12); dbg_count_f32(F, (const float*)(F.ws + WS_MST), (size_t)2048, 13); }
    if (p == 4) dbg_count_bf16(F, (const bf16_t*)(F.ws + WS_Y), (size_t)T * D, 14);
    if (p == 5) { dbg_count_bf16(F, (const bf16_t*)(F.ws + WS_HB), (size_t)T * D, 15); dbg_count_f32(F, (const float*)(F.ws + WS_HSQ), (size_t)T * 16, 16); }
    if (p == 8) dbg_count_bf16(F, (const bf16_t*)(F.ws + WS_YE), (size_t)2 * T * D, 17);
}
__device__ __forceinline__ void dbg_msq(Frame& F, size_t wsoff, int isf32, int rows, int ld, int c0, int nc) {
    float acc = 0.f; const size_t gt = (size_t)F.blk * 512 + F.tid, NT_ = (size_t)F.G * 512, n = (size_t)rows * nc;
    for (size_t i = gt; i < n; i += NT_) { const size_t r = i / nc, c = c0 + i % nc; float v = isf32 ? ((const float*)(F.ws + wsoff))[r * ld + c] : bflo((unsigned)((const bf16_t*)(F.ws + wsoff))[r * ld + c]);
        if (!(fabsf(v) < 1.0e6f)) v = 1.0e6f; acc += v * v; }
    acc = wave_sum(acc);
    if (F.lane == 0) atomicAdd((float*)(F.ws + WS_CTL) + CW_TELE + 40, acc / (float)n);
}
__device__ __forceinline__ void dbg_msq_phase(Frame& F, int p) {
    const int m = MK_DBG_TELE - 100;
    if (p == 0 && m == 0) dbg_msq(F, WS_XN, 0, T, D, 0, D);
    if (p == 0 && m == 1) dbg_msq(F, WS_WIN, 0, NPROJ, D, 0, D);
    if (p == 0 && m == 2) dbg_msq(F, WS_IFP, 1, T, 8, 0, 8);
    if (p == 1 && m == 3) dbg_msq(F, WS_PROJ, 0, T, NPROJ, 0, 1024);
    if (p == 1 && m == 4) dbg_msq(F, WS_PROJ, 0, T, NPROJ, 1024, 512);
    if (p == 1 && m == 5) dbg_msq(F, WS_PROJ, 0, T, NPROJ, 1536, 512);
    if (p == 1 && m == 6) dbg_msq(F, WS_PROJ, 0, T, NPROJ, 2048, 1024);
    if (p == 2 && m == 7) dbg_msq(F, WS_CST, 0, 2048 * 128, 128, 0, 128);
    if (p == 2 && m == 8) dbg_msq(F, WS_Y, 0, T, D, 512, 512);
    if (p == 3 && m == 9) dbg_msq(F, WS_CST, 0, 2048 * 128, 128, 0, 128);
    if (p == 4 && m == 10) dbg_msq(F, WS_Y, 0, T, D, 0, 512);
    if (p == 5 && m == 11) dbg_msq(F, WS_HB, 0, T, D, 0, D);
    if (p == 8 && m == 12) dbg_msq(F, WS_YE, 0, 2 * T, D, 0, D);
    if (p == 2 && m == 13) dbg_msq(F, WS_NST, 1, 2048, 128, 0, 128);
    if (p == 2 && m == 14) dbg_msq(F, WS_CHSC, 1, 2048, 2, 0, 2);
}
__device__ __forceinline__ void dbg_tele_out(Frame& F) {
    const unsigned* tc = (const unsigned*)(F.ws + WS_CTL) + CW_TELE; float val = 0.5f;
    if (MK_DBG_TELE == 1) { for (int sl = 1; sl < 32; ++sl) { const unsigned c = tc[sl]; if (c) { val = 100.0f * sl + (float)(31 - __builtin_clz(c)); break; } } }
    else if (MK_DBG_TELE >= 100) { val = 1000.0f * ((const float*)tc)[40]; }
    else { val = (float)tc[MK_DBG_TELE]; }
    const size_t gt = (size_t)F.blk * 512 + F.tid, NT_ = (size_t)F.G * 512;
    for (size_t i = gt; i < (size_t)T * D; i += NT_) F.out[i] = val;
}
constexpr int NPHASES = 10;
#ifndef MK_DBG_NPH
#define MK_DBG_NPH 10
#endif
__global__ void __launch_bounds__(NWAVES * 64, 2) mk_fwd(Args args) {
    extern __shared__ __attribute__((aligned(16))) unsigned char lds_raw[];
    Frame F;
    F.lds = (LAS unsigned char*)lds_raw;
    F.tid = threadIdx.x; F.lane = F.tid & 63; F.wave = __builtin_amdgcn_readfirstlane(F.tid >> 6); F.G = gridDim.x; F.blk = blockIdx.x;
    F.x = args.in[0]; F.norm1_g = args.in[1]; F.w_in = args.in[2]; F.conv_qk = args.in[3]; F.b_igate = args.in[4]; F.b_fgate = args.in[5]; F.g_mlstm_out = args.in[6];
    F.g_gmlp_v = args.in[7]; F.w_spatial = args.in[8]; F.b_spatial = args.in[9]; F.g_gmlp_out = args.in[10]; F.w_out = args.in[11]; F.norm2_g = args.in[12];
    F.w_rg = args.in[13]; F.b_rg = args.in[14]; F.w_re = args.in[15]; F.b_re = args.in[16]; F.w_gate = args.in[17]; F.w_up = args.in[18]; F.w_down = args.in[19]; F.final_g = args.in[20];
    F.out = args.out; F.ws = args.ws;
    volatile LAS unsigned* MISC = (volatile LAS unsigned*)(F.lds + MISC_OFF);
    for (int u = F.tid; u < (LDS_BYTES - TBL_OFF) / 4; u += NWAVES * 64) ((LAS unsigned*)(F.lds + TBL_OFF))[u] = 0u;
    __syncthreads();
    unsigned* ctl = (unsigned*)(F.ws + WS_CTL);
    XcdBarrier bar; bar.bar = ctl + CW_BAR; bar.x = 0; bar.st = nullptr;
    if (MK_N_LAUNCHES == 1) bar = xcd_barrier_post(ctl + CW_BAR, MISC + 8);
    const int lo = args.ph_lo, hi = args.ph_hi;
#define IN(k) (lo <= (k) && (k) < hi)
#define SEAM(k) do { if (IN(k) && IN((k) + 1)) xcd_barrier(bar); } while (0)

    if (IN(0)) { p0_prologue(F); } SEAM(0);
    if (IN(1)) {
        pg8::Gemm g{(const bf16_t*)(F.ws + WS_XN), (const bf16_t*)(F.ws + WS_WIN), T, NPROJ, D, nullptr}; pg8::StaticOrder S; S.init(T, NPROJ, F.G, F.blk);
        pg8::EpiP1 E{(bf16_t*)(F.ws + WS_PROJ)};
        pg8::gemm_phase<pg8::EpiP1, pg8::StaticOrder, false>(F.lds, g, S, E);
    } SEAM(1);
    if (IN(2)) {
        p2a_block(F); gmlp_tile(F, F.blk); BAR_LDS();
    } SEAM(2);
    if (IN(3)) { scan_phase(F); } SEAM(3);
    if (IN(4)) { p4_block(F); } SEAM(4);
    if (IN(5)) {
        pg8::Gemm g{(const bf16_t*)(F.ws + WS_Y), (const bf16_t*)(F.ws + WS_WOUT), T, D, D, nullptr}; pg8::StaticOrder S; S.init(T, D, F.G, F.blk);
        pg8::EpiP5 E{F.x, (bf16_t*)(F.ws + WS_HB), (float*)(F.ws + WS_HSQ), F.ws + WS_HB8};
        pg8::gemm_phase<pg8::EpiP5, pg8::StaticOrder, false>(F.lds, g, S, E);
    } SEAM(5);
    if (IN(6)) { router_phase(F); } SEAM(6);
    if (IN(7) || IN(8)) {
        LAS int* tbl = (LAS int*)(F.lds + TBL_OFF);
        __syncthreads();
        if (F.tid == 0) { int acc = 0; const unsigned* GCNT = ctl + CW_GCNT;
            for (int e = 0; e < NE; ++e) { const int cnt = (int)__hip_atomic_load(GCNT + e, __ATOMIC_RELAXED, __HIP_MEMORY_SCOPE_AGENT); tbl[e] = acc; tbl[33 + e] = cnt; acc += (cnt + 255) >> 8; }
            tbl[32] = acc; }
        __syncthreads();
        if (IN(7)) {
            pg8::Gemm g{(const bf16_t*)(F.ws + WS_HB8), (const bf16_t*)(F.ws + WS_WGU), 0, 0, D / 2, (const unsigned*)(F.ws + WS_LIST)};
            pg8::MoeOrder S{tbl, tbl[32] * 4, F.G, F.blk};
            pg8::EpiGU E{(const float*)(F.ws + WS_SRSTD), F.ws + WS_HID};
            pg8::gemm_phase<pg8::EpiGU, pg8::MoeOrder, true, true>(F.lds, g, S, E);
        }
        SEAM(7);
        if (IN(8)) {
            pg8::Gemm g{(const bf16_t*)(F.ws + WS_HID), (const bf16_t*)(F.ws + WS_WD), 0, 0, DFF / 2, nullptr};
            pg8::MoeOrder S{tbl, tbl[32] * 4, F.G, F.blk};
            pg8::EpiDown E{(const unsigned*)(F.ws + WS_LIST), (const float*)(F.ws + WS_SW), (bf16_t*)(F.ws + WS_YE)};
            pg8::gemm_phase<pg8::EpiDown, pg8::MoeOrder, false, true>(F.lds, g, S, E);
        }
    }
    SEAM(8);
    if (IN(9)) { final_phase(F); }
    if (lo >= 20 && lo < 30) { if (MK_DBG_TELE >= 100) dbg_msq_phase(F, lo - 20); else dbg_check_phase(F, lo - 20); }
    if (lo == 30) dbg_tele_out(F);
#undef IN
#undef SEAM
}

extern "C" void kernel_launch(void* const* d_in, const int* in_sizes, int n_in, void* d_out, int out_size, void* d_ws, size_t ws_size, hipStream_t stream) {
    static int grid = 0;
    if (grid == 0) {
        if (n_in != 21 || out_size != T * D || ws_size < WS_END) { fprintf(stderr, "kernel_launch: unexpected shapes (n_in %d, out %d, ws %zu)\n", n_in, out_size, ws_size); grid = -1; return; }
        int dev = 0, cus = 0, per_cu = 0;
        if (hipGetDevice(&dev) != hipSuccess || hipDeviceGetAttribute(&cus, hipDeviceAttributeMultiprocessorCount, dev) != hipSuccess) { grid = -1; return; }
        if (hipFuncSetAttribute((const void*)mk_fwd, hipFuncAttributeMaxDynamicSharedMemorySize, LDS_BYTES) != hipSuccess) { fprintf(stderr, "kernel_launch: hipFuncSetAttribute failed\n"); grid = -1; return; }
        if (hipOccupancyMaxActiveBlocksPerMultiprocessor(&per_cu, (const void*)mk_fwd, NWAVES * 64, LDS_BYTES) != hipSuccess || per_cu < 1) { fprintf(stderr, "kernel_launch: occupancy query says %d blocks/CU\n", per_cu); (void)hipGetLastError(); grid = -1; return; }
        if (cus < 256) { fprintf(stderr, "kernel_launch: needs 256 CUs (got %d)\n", cus); grid = -1; return; }
        grid = 256;
    }
    if (grid < 0) return;
    (void)hipMemsetAsync((char*)d_ws + WS_CTL, 0, CTL_ZERO_BYTES, stream);
    Args a{};
    for (int i = 0; i < 21; ++i) a.in[i] = (const float*)d_in[i];
    a.out = (float*)d_out; a.ws = (unsigned char*)d_ws;
    if (MK_N_LAUNCHES == 1) {
        a.ph_lo = 0; a.ph_hi = NPHASES;
        hipLaunchKernelGGL(mk_fwd, dim3(grid), dim3(NWAVES * 64), LDS_BYTES, stream, a);
    } else {
        for (int p = 0; p < MK_DBG_NPH; ++p) { a.ph_lo = p; a.ph_hi = p + 1; hipLaunchKernelGGL(mk_fwd, dim3(grid), dim3(NWAVES * 64), LDS_BYTES, stream, a);
            if (MK_DBG_TELE) { a.ph_lo = 20 + p; a.ph_hi = 21 + p; hipLaunchKernelGGL(mk_fwd, dim3(grid), dim3(NWAVES * 64), LDS_BYTES, stream, a); } }
        if (MK_DBG_TELE) { a.ph_lo = 30; a.ph_hi = 31; hipLaunchKernelGGL(mk_fwd, dim3(grid), dim3(NWAVES * 64), LDS_BYTES, stream, a); }
    }
}
```

```cpp
#include <hip/hip_runtime.h>
#include <cstdio>
#include <cstdint>

#ifndef MK_N_LAUNCHES
#define MK_N_LAUNCHES 1
#endif

#ifndef MK_DBG_TELE
#define MK_DBG_TELE 0
#endif
#ifndef MK_DBG_MOE
#define MK_DBG_MOE 1.0f
#endif
#define LAS __attribute__((address_space(3)))
typedef unsigned short bf16_t;
typedef short bf16x8 __attribute__((ext_vector_type(8)));
typedef float f32x4 __attribute__((ext_vector_type(4)));
typedef float f32x2 __attribute__((ext_vector_type(2)));
typedef unsigned u32x4 __attribute__((ext_vector_type(4)));
typedef unsigned u32x2 __attribute__((ext_vector_type(2)));

constexpr int T = 32768, D = 1024, SEQ = 8192, NPROJ = 3072, DIN = 3080;
constexpr int NE = 32, DFF = 512, CAP = 65536;
constexpr float EPS = 1e-6f;
constexpr int NWAVES = 8;

constexpr size_t MiB = 1u << 20;
constexpr size_t WS_CTL = 0, CTL_ZERO_BYTES = 256 * 1024;
constexpr size_t WS_IFP = 1 * MiB;
constexpr size_t WS_CHSC = 2 * MiB;
constexpr size_t WS_MST = 2 * MiB + 65536;
constexpr size_t WS_NST = 3 * MiB;
constexpr size_t WS_HSQ = 4 * MiB;
constexpr size_t WS_VSQ = 7 * MiB;
constexpr size_t WS_WR = 6 * MiB;
constexpr size_t WS_WSP = 6 * MiB + 512 * 1024;
constexpr size_t WS_LIST = 8 * MiB;
constexpr size_t WS_SRSTD = 16 * MiB;
constexpr size_t WS_SW = 24 * MiB;
constexpr size_t WS_WIN = 32 * MiB;
constexpr size_t WS_WOUT = 38 * MiB;
constexpr size_t WS_WGU = 40 * MiB;
constexpr size_t WS_WD = 72 * MiB;
constexpr size_t WS_HB8 = 88 * MiB;
constexpr size_t WS_XN = 136 * MiB;
constexpr size_t WS_Y = 136 * MiB;
constexpr size_t WS_PROJ = 200 * MiB;
constexpr size_t WS_YE = 200 * MiB;
constexpr size_t WS_HB = 328 * MiB;
constexpr size_t WS_CST = 392 * MiB;
constexpr size_t WS_HID = 392 * MiB;
constexpr size_t WS_END = 464 * MiB;
constexpr int CW_GCNT = 64;
constexpr int CW_BAR = 4096;

constexpr int RING_BYTES = 131072;
constexpr int TBL_OFF = RING_BYTES;
constexpr int MISC_OFF = RING_BYTES + 1024;
constexpr int LDS_BYTES = 147456;

typedef __bf16 bf16x2_t __attribute__((ext_vector_type(2)));
__device__ __forceinline__ unsigned cvt_pk_bf16(float lo, float hi) { f32x2 v = {lo, hi}; bf16x2_t b = __builtin_convertvector(v, bf16x2_t); return __builtin_bit_cast(unsigned, b); }
__device__ __forceinline__ unsigned f2bf(float f) { unsigned u = __builtin_bit_cast(unsigned, f); return (u + 0x7fffu + ((u >> 16) & 1u)) >> 16; }
__device__ __forceinline__ float bflo(unsigned w) { return __builtin_bit_cast(float, w << 16); }
__device__ __forceinline__ float bfhi(unsigned w) { return __builtin_bit_cast(float, w & 0xffff0000u); }
__device__ __forceinline__ float sigmoid_f(float x) { return __builtin_amdgcn_rcpf(1.0f + __expf(-x)); }
__device__ __forceinline__ float silu_f(float x) { return x * __builtin_amdgcn_rcpf(1.0f + __expf(-x)); }
__device__ __forceinline__ float gelu_f(float x) { const float u = 0.7978845608028654f * (x + 0.044715f * x * x * x); return x * __builtin_amdgcn_rcpf(1.0f + __expf(-2.0f * u)); }
__device__ __forceinline__ void unpack8(const u32x4 r, float (&v)[8]) { v[0] = bflo(r.x); v[1] = bfhi(r.x); v[2] = bflo(r.y); v[3] = bfhi(r.y); v[4] = bflo(r.z); v[5] = bfhi(r.z); v[6] = bflo(r.w); v[7] = bfhi(r.w); }
__device__ __forceinline__ float wave_sum(float v) {
#pragma unroll
    for (int o = 1; o < 64; o <<= 1) v += __shfl_xor(v, o);
    return v;
}
__device__ __forceinline__ float wave_max(float v) {
#pragma unroll
    for (int o = 1; o < 64; o <<= 1) v = fmaxf(v, __shfl_xor(v, o));
    return v;
}
typedef int i32x4 __attribute__((ext_vector_type(4)));
typedef int i32x8 __attribute__((ext_vector_type(8)));
__device__ __forceinline__ unsigned cvt4_fp8(float a, float b, float c, float d) { int w = 0; w = __builtin_amdgcn_cvt_pk_fp8_f32(a, b, w, false); w = __builtin_amdgcn_cvt_pk_fp8_f32(c, d, w, true); return (unsigned)w; }
constexpr float FP8_WSCALE = 64.0f, FP8_ASCALE = 8.0f, FP8_YSCALE = 64.0f;
#define MFMA16(a, b, c) __builtin_amdgcn_mfma_f32_16x16x32_bf16((a), (b), (c), 0, 0, 0)
#define LDS_WAIT() asm volatile("s_waitcnt lgkmcnt(0)" ::: "memory")
#define VM_WAIT() asm volatile("s_waitcnt vmcnt(0)" ::: "memory")

namespace pg8 {
constexpr int BM = 256, BK = 64, HALF = 128, HTB = HALF * BK * 2, STAGE_BYTES = 8 * HTB, NXCD = 8, WGM = 8;
__host__ __device__ __forceinline__ int lds_byte(int r, int c) { const int st = (r >> 4) * 2 + (c >> 5), rr = r & 15, cc = c & 31, ob = rr * 64 + cc * 2; return st * 1024 + (ob ^ (((ob >> 9) & 1) << 5)); }
__host__ __device__ __forceinline__ void stage_rc(int b, int& R, int& C) { const int st = b / 1024, sb = b % 1024, swz = sb ^ (((sb >> 9) & 1) << 5); R = (st >> 1) * 16 + swz / 64; C = (st & 1) * 32 + (swz % 64) / 2; }
__host__ __device__ __forceinline__ int perm32(int rho) { const int n = rho >> 4, i = rho & 15; return 8 * (i >> 2) + 4 * n + (i & 3); }

struct Unit { int pm, pn, lbase, nvalid; };
struct Gemm { const bf16_t* A; const bf16_t* Bt; int M, N, K; const unsigned* list; };

struct StaticOrder {
    int nM, nN, nwg, G, c;
    __device__ void init(int M, int N, int G_, int c_) { nM = M / BM; nN = N / BM; nwg = nM * nN; G = G_; c = c_; }
    __device__ bool next(int i, Unit& u) const {
        const long L = (long)i * G + c; if (L >= nwg) return false;
        int wgid = (int)L; { const int q = nwg / NXCD, r = nwg % NXCD, xcd = wgid % NXCD, off = wgid / NXCD; wgid = (xcd < r ? xcd * (q + 1) : r * (q + 1) + (xcd - r) * q) + off; }
        const int nig = WGM * nN, gid = wgid / nig, fm = gid * WGM, gsz = (nM - fm) < WGM ? (nM - fm) : WGM;
        u.pm = fm + ((wgid % nig) % gsz); u.pn = (wgid % nig) / gsz; u.lbase = 0; u.nvalid = 256; return true;
    }
};
struct MoeOrder {
    const LAS int* tbl; int nunits, G, c;
    __device__ bool next(int i, Unit& u) const {
        const long L = (long)i * G + c; if (L >= nunits) return false;
        int wgid = (int)L; { const int q = nunits / NXCD, r = nunits % NXCD, xcd = wgid % NXCD, off = wgid / NXCD; wgid = (xcd < r ? xcd * (q + 1) : r * (q + 1) + (xcd - r) * q) + off; }
        const int mt = wgid >> 2, pn = wgid & 3;
        int e = 0;
#pragma unroll
        for (int s = 16; s >= 1; s >>= 1) if (tbl[e + s] <= mt) e += s;
        const int lt = mt - tbl[e]; const int rem = tbl[33 + e] - lt * 256;
        u.pm = mt; u.pn = e * 4 + pn; u.lbase = e * CAP + lt * 256; u.nvalid = rem < 256 ? rem : 256; return true;
    }
};

struct EpiP1 {
    static constexpr bool PERM = true;
    bf16_t* O; float* VSQ;
    __device__ __forceinline__ void operator()(const f32x4 (&acc)[2][2][4][2], const Unit& u, int wr, int wc, int fr, int fq) const {
        const int act = (u.pn < 6) ? 0 : (u.pn < 8 ? 1 : 2);
        const int row0 = u.pm * BM + wr * 64 + fr, col0 = u.pn * BM + wc * 32 + 8 * fq;
#pragma unroll
        for (int ai = 0; ai < 2; ++ai)
#pragma unroll
            for (int m = 0; m < 4; ++m) { bf16_t* rowp = O + (size_t)(row0 + ai * HALF + m * 16) * NPROJ + col0; float ss = 0.f;
#pragma unroll
                for (int bj = 0; bj < 2; ++bj) { f32x4 v0 = acc[ai][bj][m][0], v1 = acc[ai][bj][m][1];
                    if (act == 1) {
#pragma unroll
                        for (int j = 0; j < 4; ++j) { v0[j] = sigmoid_f(v0[j]); v1[j] = sigmoid_f(v1[j]); }
                    } else if (act == 2) {
#pragma unroll
                        for (int j = 0; j < 4; ++j) { v0[j] = gelu_f(v0[j]); v1[j] = gelu_f(v1[j]); }
                        ss += (v0[0] * v0[0] + v0[1] * v0[1]) + (v0[2] * v0[2] + v0[3] * v0[3]) + (v1[0] * v1[0] + v1[1] * v1[1]) + (v1[2] * v1[2] + v1[3] * v1[3]);
                    }
                    u32x4 w; w.x = cvt_pk_bf16(v0[0], v0[1]); w.y = cvt_pk_bf16(v0[2], v0[3]); w.z = cvt_pk_bf16(v1[0], v1[1]); w.w = cvt_pk_bf16(v1[2], v1[3]);
                    *(u32x4*)(rowp + bj * HALF) = w; }
                if (u.pn >= 10) { ss += __shfl_xor(ss, 16); ss += __shfl_xor(ss, 32); if (fq == 0) VSQ[(size_t)(row0 + ai * HALF + m * 16) * 8 + (u.pn - 10) * 4 + wc] = ss; } }
    }
};
struct EpiP5 {
    static constexpr bool PERM = true;
    const float* X; bf16_t* HB; float* HSQ; unsigned char* HB8;
    __device__ __forceinline__ void operator()(const f32x4 (&acc)[2][2][4][2], const Unit& u, int wr, int wc, int fr, int fq) const {
        const int row0 = u.pm * BM + wr * 64 + fr, col0 = u.pn * BM + wc * 32 + 8 * fq;
#pragma unroll
        for (int ai = 0; ai < 2; ++ai)
#pragma unroll
            for (int m = 0; m < 4; ++m) { const int row = row0 + ai * HALF + m * 16; float ss = 0.f;
#pragma unroll
                for (int bj = 0; bj < 2; ++bj) { const size_t off = (size_t)row * D + col0 + bj * HALF;
                    const f32x4 x0 = *(const f32x4*)(X + off), x1 = *(const f32x4*)(X + off + 4);
                    const f32x4 h0 = acc[ai][bj][m][0] + x0, h1 = acc[ai][bj][m][1] + x1;
                    ss += (h0[0] * h0[0] + h0[1] * h0[1]) + (h0[2] * h0[2] + h0[3] * h0[3]) + (h1[0] * h1[0] + h1[1] * h1[1]) + (h1[2] * h1[2] + h1[3] * h1[3]);
                    u32x4 w; w.x = cvt_pk_bf16(h0[0], h0[1]); w.y = cvt_pk_bf16(h0[2], h0[3]); w.z = cvt_pk_bf16(h1[0], h1[1]); w.w = cvt_pk_bf16(h1[2], h1[3]);
                    *(u32x4*)(HB + off) = w;
                    u32x2 w8; w8.x = cvt4_fp8(h0[0] * FP8_ASCALE, h0[1] * FP8_ASCALE, h0[2] * FP8_ASCALE, h0[3] * FP8_ASCALE); w8.y = cvt4_fp8(h1[0] * FP8_ASCALE, h1[1] * FP8_ASCALE, h1[2] * FP8_ASCALE, h1[3] * FP8_ASCALE);
                    *(u32x2*)(HB8 + off) = w8; }
                ss += __shfl_xor(ss, 16); ss += __shfl_xor(ss, 32);
                if (fq == 0) HSQ[(size_t)row * 16 + u.pn * 4 + wc] = ss; }
    }
};
struct EpiGU {
    static constexpr bool PERM = true;
    const float* SRSTD; unsigned char* HID;
    __device__ __forceinline__ void operator()(const f32x4 (&acc)[2][2][4][2], const Unit& u, int wr, int wc, int fr, int fq) const {
        const int col0 = (u.pn & 3) * 128 + wc * 32 + 8 * fq;
#pragma unroll
        for (int ai = 0; ai < 2; ++ai)
#pragma unroll
            for (int m = 0; m < 4; ++m) { const int lr = ai * HALF + wr * 64 + m * 16 + fr;
                const float rs = (lr < u.nvalid) ? SRSTD[u.lbase + lr] * (1.0f / (FP8_WSCALE * FP8_ASCALE)) : 0.f;
                float hv[8];
#pragma unroll
                for (int n = 0; n < 2; ++n)
#pragma unroll
                    for (int j = 0; j < 4; ++j) { const float g = acc[ai][0][m][n][j] * rs, up = acc[ai][1][m][n][j] * rs; hv[n * 4 + j] = silu_f(g) * up; }
                u32x2 w; w.x = cvt4_fp8(hv[0] * FP8_ASCALE, hv[1] * FP8_ASCALE, hv[2] * FP8_ASCALE, hv[3] * FP8_ASCALE); w.y = cvt4_fp8(hv[4] * FP8_ASCALE, hv[5] * FP8_ASCALE, hv[6] * FP8_ASCALE, hv[7] * FP8_ASCALE);
                *(u32x2*)(HID + (size_t)(u.pm * BM + lr) * DFF + col0) = w; }
    }
};
struct EpiDown {
    static constexpr bool PERM = true;
    const unsigned* LIST; const float* SW; unsigned char* YE;
    __device__ __forceinline__ void operator()(const f32x4 (&acc)[2][2][4][2], const Unit& u, int wr, int wc, int fr, int fq) const {
        const int col0 = (u.pn & 3) * BM + wc * 32 + 8 * fq;
#pragma unroll
        for (int ai = 0; ai < 2; ++ai)
#pragma unroll
            for (int m = 0; m < 4; ++m) { const int lr = ai * HALF + wr * 64 + m * 16 + fr;
                if (lr < u.nvalid) { const unsigned pair = LIST[u.lbase + lr]; const float w8 = SW[u.lbase + lr] * (FP8_YSCALE / (FP8_WSCALE * FP8_ASCALE));
                    unsigned char* rowp = YE + (size_t)pair * D + col0;
#pragma unroll
                    for (int bj = 0; bj < 2; ++bj) { const f32x4 v0 = acc[ai][bj][m][0] * w8, v1 = acc[ai][bj][m][1] * w8;
                        u32x2 w; w.x = cvt4_fp8(v0[0], v0[1], v0[2], v0[3]); w.y = cvt4_fp8(v1[0], v1[1], v1[2], v1[3]);
                        *(u32x2*)(rowp + bj * HALF) = w; } } }
    }
};

template <class Epi, class Sched, bool GATHER, bool FP8 = false>
__device__ __forceinline__ void gemm_phase(LAS unsigned char* lds, const Gemm g, const Sched& S, const Epi& E) {
    const int tid = threadIdx.x, wid = __builtin_amdgcn_readfirstlane(tid >> 6), lane = tid & 63, wr = wid >> 2, wc = wid & 3, fr = lane & 15, fq = lane >> 4;
    const int K = g.K, nt = K / BK;
    unsigned voffB[2], vAc[2][2], vAn[2][2]; int sR[2], sC[2];
    const size_t kstep = (size_t)(BK * 2);
    const size_t hstep = (size_t)HALF * K * 2;
    const size_t tstep = 2 * hstep;
#pragma unroll
    for (int i = 0; i < 2; ++i) { int R, C; stage_rc(tid * 16 + i * 8192, R, C); const int Rb = Epi::PERM ? ((R & ~31) + perm32(R & 31)) : R;
        sR[i] = R; sC[i] = C; voffB[i] = (unsigned)(Rb * K + C) * 2u;
        vAc[0][i] = (unsigned)(R * K + C) * 2u; vAc[1][i] = vAc[0][i] + (unsigned)hstep; vAn[0][i] = vAc[0][i]; vAn[1][i] = vAc[1][i]; }
    const unsigned ldsw = (unsigned)wid * 1024u;
    const int aoff = lds_byte(wr * 64 + fr, fq * 8), boff = lds_byte(wc * 32 + fr, fq * 8);
#define PG8_SA(b, h) (((b) * 2 + (h)) * HTB)
#define PG8_SB(b, h) ((4 + (b) * 2 + (h)) * HTB)
#define PG8_STAGE(bufoff, gbase, voff) do { _Pragma("unroll") for (int _i = 0; _i < 2; ++_i) \
        __builtin_amdgcn_global_load_lds((const unsigned*)((const char*)(gbase) + (voff)[_i]), (LAS unsigned*)(lds + (bufoff) + ldsw + _i * 8192), 16, 0, 0); } while (0)
#define PG8_LDA(dst, b, h) do { _Pragma("unroll") for (int m = 0; m < 4; ++m) _Pragma("unroll") for (int k = 0; k < 2; ++k) dst[m][k] = *(const LAS bf16x8*)(lds + PG8_SA(b, h) + aoff + m * 2048 + k * 1024); } while (0)
#define PG8_LDB(dst, b, h) do { _Pragma("unroll") for (int n = 0; n < 2; ++n) _Pragma("unroll") for (int k = 0; k < 2; ++k) dst[n][k] = *(const LAS bf16x8*)(lds + PG8_SB(b, h) + boff + n * 2048 + k * 1024); } while (0)
#define PG8_MMA(ai, bj, At, Bt) do { __builtin_amdgcn_s_setprio(1); _Pragma("unroll") for (int m = 0; m < 4; ++m) _Pragma("unroll") for (int n = 0; n < 2; ++n) _Pragma("unroll") for (int k = 0; k < 2; ++k) \
        acc[ai][bj][m][n] = __builtin_amdgcn_mfma_f32_16x16x32_bf16(Bt[n][k], At[m][k], acc[ai][bj][m][n], 0, 0, 0); __builtin_amdgcn_s_setprio(0); } while (0)
#define PG8_CAT(x0, x1) __builtin_shufflevector(__builtin_bit_cast(i32x4, x0), __builtin_bit_cast(i32x4, x1), 0, 1, 2, 3, 4, 5, 6, 7)
#define PG8_MMA8(ai, bj, At, Bt) do { __builtin_amdgcn_s_setprio(1); _Pragma("unroll") for (int m = 0; m < 4; ++m) _Pragma("unroll") for (int n = 0; n < 2; ++n) { \
        const i32x8 b8_ = PG8_CAT(Bt[n][0], Bt[n][1]), a8_ = PG8_CAT(At[m][0], At[m][1]); \
        asm volatile("v_mfma_scale_f32_16x16x128_f8f6f4 %0, %1, %2, %0, %3, %3 op_sel_hi:[0,0,0]" : "+v"(acc[ai][bj][m][n]) : "v"(b8_), "v"(a8_), "v"(sc1_)); } __builtin_amdgcn_s_setprio(0); } while (0)
#define PG8_MM(ai, bj, At, Bt) do { if constexpr (FP8) { PG8_MMA8(ai, bj, At, Bt); } else { PG8_MMA(ai, bj, At, Bt); } } while (0)
#define PG8_WAIT_V(n) asm volatile("s_waitcnt vmcnt(" #n ")" ::: "memory")
#define PG8_WAIT_L(n) asm volatile("s_waitcnt lgkmcnt(" #n ")" ::: "memory")
#define PG8_BAR __builtin_amdgcn_s_barrier()
#define PG8_SCHED __builtin_amdgcn_sched_barrier(0)
#define PG8_GATHER(dst, un) do { _Pragma("unroll") for (int _h = 0; _h < 2; ++_h) _Pragma("unroll") for (int _i = 0; _i < 2; ++_i) { \
        const int _lr = _h * HALF + sR[_i]; unsigned _p = 0u; if (_lr < (un).nvalid) _p = g.list[(un).lbase + _lr]; \
        dst[_h][_i] = ((_p >> 1) * (unsigned)K + (unsigned)sC[_i]) * 2u; asm volatile("" : "+v"(dst[_h][_i])); } } while (0)
    Unit cur, nxt; int ui = 0;
    if (!S.next(0, cur)) return;
    f32x4 acc[2][2][4][2];
#pragma unroll
    for (int a = 0; a < 2; ++a)
#pragma unroll
        for (int b = 0; b < 2; ++b)
#pragma unroll
            for (int m = 0; m < 4; ++m)
#pragma unroll
                for (int n = 0; n < 2; ++n) acc[a][b][m][n] = (f32x4){0.f, 0.f, 0.f, 0.f};
    bf16x8 At[4][2], B0[2][2], B1[2][2];
    const int sc1_ = 0x7f7f7f7f;
    const char* cA = GATHER ? (const char*)g.A : (const char*)g.A + (size_t)cur.pm * tstep; const char* cB = (const char*)g.Bt + (size_t)cur.pn * tstep;
    if constexpr (GATHER) { PG8_GATHER(vAc, cur); }
    PG8_STAGE(PG8_SB(0, 0), cB, voffB); PG8_STAGE(PG8_SB(0, 1), cB + hstep, voffB); PG8_STAGE(PG8_SA(0, 0), cA, vAc[0]); PG8_STAGE(PG8_SA(0, 1), cA, vAc[1]);
    if (wr == 1) PG8_BAR;
    PG8_WAIT_V(2); PG8_BAR;
    PG8_STAGE(PG8_SB(1, 0), cB + kstep, voffB); PG8_STAGE(PG8_SA(1, 0), cA + kstep, vAc[0]); PG8_STAGE(PG8_SB(1, 1), cB + hstep + kstep, voffB);
    PG8_WAIT_V(6); PG8_BAR;
    for (;;) {
        const bool has_next = S.next(ui + 1, nxt);
        const char* nA = has_next ? (GATHER ? (const char*)g.A : (const char*)g.A + (size_t)nxt.pm * tstep) : cA; const char* nB = has_next ? (const char*)g.Bt + (size_t)nxt.pn * tstep : cB;
        if constexpr (GATHER) {
            if (has_next) { PG8_GATHER(vAn, nxt); }
            else {
#pragma unroll
                for (int h = 0; h < 2; ++h)
#pragma unroll
                    for (int i = 0; i < 2; ++i) vAn[h][i] = vAc[h][i];
            }
        }
        _Pragma("nounroll") for (int t = 0; t < nt; t += 2) {
            const bool last = (t == nt - 2);
            const char* a1 = cA + (size_t)(t + 1) * kstep;
            const char* a2 = last ? nA : cA + (size_t)(t + 2) * kstep; const char* b2 = last ? nB : cB + (size_t)(t + 2) * kstep;
            const char* a3 = a2 + kstep; const char* b3 = b2 + kstep;
            unsigned vA2[2][2];
#pragma unroll
            for (int h = 0; h < 2; ++h)
#pragma unroll
                for (int i = 0; i < 2; ++i) vA2[h][i] = (GATHER && last) ? vAn[h][i] : vAc[h][i];
            PG8_LDB(B0, 0, 0); PG8_LDB(B1, 0, 1); PG8_SCHED; PG8_LDA(At, 0, 0); PG8_STAGE(PG8_SA(1, 1), a1, vAc[1]);
            PG8_WAIT_V(8); PG8_WAIT_L(0); PG8_BAR; PG8_MM(0, 0, At, B0); PG8_MM(0, 1, At, B1); PG8_BAR; PG8_SCHED;
            PG8_LDA(At, 0, 1); PG8_STAGE(PG8_SB(0, 0), b2, voffB); PG8_STAGE(PG8_SB(0, 1), b2 + hstep, voffB); PG8_STAGE(PG8_SA(0, 0), a2, vA2[0]);
            PG8_WAIT_V(8); PG8_WAIT_L(0); PG8_BAR; PG8_MM(1, 0, At, B0); PG8_MM(1, 1, At, B1); PG8_BAR; PG8_SCHED;
            PG8_LDB(B0, 1, 0); PG8_LDB(B1, 1, 1); PG8_SCHED; PG8_LDA(At, 1, 0); PG8_STAGE(PG8_SA(0, 1), a2, vA2[1]);
            PG8_WAIT_V(8); PG8_WAIT_L(0); PG8_BAR; PG8_MM(0, 0, At, B0); PG8_MM(0, 1, At, B1); PG8_BAR; PG8_SCHED;
            PG8_LDA(At, 1, 1); PG8_STAGE(PG8_SB(1, 0), b3, voffB); PG8_STAGE(PG8_SB(1, 1), b3 + hstep, voffB); PG8_STAGE(PG8_SA(1, 0), a3, vA2[0]);
            PG8_WAIT_V(8); PG8_WAIT_L(0); PG8_BAR; PG8_MM(1, 0, At, B0); PG8_MM(1, 1, At, B1); PG8_BAR; PG8_SCHED;
        }
        if (wr == 0) PG8_BAR;
        if constexpr (FP8) asm volatile("s_nop 15\n\ts_nop 7" ::: "memory");
        E(acc, cur, wr, wc, fr, fq);
        if (!has_next) break;
#pragma unroll
        for (int a = 0; a < 2; ++a)
#pragma unroll
            for (int b = 0; b < 2; ++b)
#pragma unroll
                for (int m = 0; m < 4; ++m)
#pragma unroll
                    for (int n = 0; n < 2; ++n) acc[a][b][m][n] = (f32x4){0.f, 0.f, 0.f, 0.f};
        cur = nxt; cA = nA; cB = nB; ++ui;
        if constexpr (GATHER) {
#pragma unroll
            for (int h = 0; h < 2; ++h)
#pragma unroll
                for (int i = 0; i < 2; ++i) vAc[h][i] = vAn[h][i];
        }
        if (wr == 1) PG8_BAR;
    }
    PG8_WAIT_V(0);
    PG8_BAR;
#undef PG8_SA
#undef PG8_SB
#undef PG8_STAGE
#undef PG8_LDA
#undef PG8_LDB
#undef PG8_MMA
#undef PG8_MMA8
#undef PG8_MM
#undef PG8_CAT
#undef PG8_WAIT_V
#undef PG8_WAIT_L
#undef PG8_BAR
#undef PG8_SCHED
#undef PG8_GATHER
}
}

typedef __attribute__((address_space(1))) unsigned gu32;
#define XB_TMO      128
#define XB_XCNT(j)  (256  + 64 * (j))
#define XB_XSUB(j)  (1280 + 64 * (j))
#define XB_XGEN(j)  (2304 + 64 * (j))
#define XB_TOP      3328
#define XB_TOPGEN   3392
#define XCD_BAR_WORDS 3456
#define XB_SPIN_CAP (1u << 18)
__device__ __forceinline__ unsigned xb_ld(unsigned* p)              { return __hip_atomic_load(p, __ATOMIC_RELAXED, __HIP_MEMORY_SCOPE_AGENT); }
__device__ __forceinline__ unsigned xb_add(unsigned* p, unsigned v) { return __hip_atomic_fetch_add(p, v, __ATOMIC_RELAXED, __HIP_MEMORY_SCOPE_AGENT); }
__device__ __forceinline__ unsigned xb_xcc_id() { return (unsigned)__builtin_amdgcn_s_getreg((3 << 11) | 20) & 0xFu; }
#define XB_SPIN(cond, bar) do { unsigned _sp = 0; while (cond) { __builtin_amdgcn_s_sleep(1); \
    if ((++_sp & 255u) == 0u) { if (xb_ld(&(bar)[XB_TMO])) break; if (_sp > XB_SPIN_CAP) { atomicAdd(&(bar)[XB_TMO], 1u); break; } } } } while (0)
struct XcdBarrier { unsigned* bar; unsigned x; volatile LAS unsigned* st; };
__device__ __forceinline__ XcdBarrier xcd_barrier_post(unsigned* bar, volatile LAS unsigned* st) {
    XcdBarrier b; b.bar = bar; b.x = xb_xcc_id(); b.st = st;
    if (threadIdx.x == 0) (void)xb_add(&bar[XB_XCNT(b.x)], 1u);
    return b;
}
__device__ __forceinline__ void xcd_barrier_complete(unsigned* bar, unsigned x, unsigned& nloc, unsigned& nx) {
    const unsigned G = gridDim.x * gridDim.y * gridDim.z;
    unsigned sum, cnt, mine, sp = 0u;
    for (;;) {
        sum = 0u; cnt = 0u; mine = 0u;
#pragma unroll
        for (unsigned j = 0; j < 16; ++j) { const unsigned c = xb_ld(&bar[XB_XCNT(j)]); sum += c; cnt += (c > 0u) ? 1u : 0u; mine = (j == x) ? c : mine; }
        if (sum == G) break;
        __builtin_amdgcn_s_sleep(1);
        if ((++sp & 255u) == 0u) { if (xb_ld(&bar[XB_TMO])) break; if (sp > XB_SPIN_CAP) { atomicAdd(&bar[XB_TMO], 1u); break; } }
    }
    nloc = mine > 0u ? mine : 1u; nx = cnt > 0u ? cnt : 1u;
}
__device__ __forceinline__ void xcd_barrier(const XcdBarrier& b) {
    asm volatile("s_waitcnt vmcnt(0)" ::: "memory");
    __syncthreads();
    if (threadIdx.x == 0) {
        unsigned* bar = b.bar;
        __builtin_amdgcn_s_waitcnt(0);
        unsigned nloc = b.st[0], nx = b.st[1];
        if (nloc == 0u) { xcd_barrier_complete(bar, b.x, nloc, nx); b.st[0] = nloc; b.st[1] = nx; }
        const unsigned old = xb_add(&bar[XB_XSUB(b.x)], 1u);
        const unsigned gen = old / nloc;
        if (old + 1u == (gen + 1u) * nloc) {
            __builtin_amdgcn_fence(__ATOMIC_RELEASE, "agent");
            asm volatile("s_waitcnt vmcnt(0)" ::: "memory");
            const unsigned og = xb_add(&bar[XB_TOP], 1u);
            const unsigned tg = og / nx;
            if (og + 1u == (tg + 1u) * nx) xb_add(&bar[XB_TOPGEN], 1u);
            else XB_SPIN(xb_ld(&bar[XB_TOPGEN]) == tg, bar);
            __builtin_amdgcn_fence(__ATOMIC_ACQUIRE, "agent");
            xb_add(&bar[XB_XGEN(b.x)], 1u);
            asm volatile("s_waitcnt vmcnt(0)" ::: "memory");
        } else {
            XB_SPIN(xb_ld(&bar[XB_XGEN(b.x)]) == gen, bar);
            __builtin_amdgcn_fence(__ATOMIC_ACQUIRE, "agent");
            asm volatile("s_waitcnt vmcnt(0)" ::: "memory");
        }
    }
    __syncthreads();
}

struct Args { const float* in[21]; float* out; unsigned char* ws; int ph_lo, ph_hi; };
struct Frame {
    LAS unsigned char* lds; int tid, lane, wave, G, blk;
    const float *x, *norm1_g, *w_in, *conv_qk, *b_igate, *b_fgate, *g_mlstm_out, *g_gmlp_v, *w_spatial, *b_spatial, *g_gmlp_out, *w_out, *norm2_g,
        *w_rg, *b_rg, *w_re, *b_re, *w_gate, *w_up, *w_down, *final_g;
    float* out; unsigned char* ws;
};

__device__ __forceinline__ void transpose_item64(const float* W, int ldw, int col0, int k0, bf16_t* dst, int K, const float* kscale, LAS unsigned* Tt, int lane) {
    const int kp = lane >> 4, nc = lane & 15;
    f32x4 a[8], b[8];
    const float* src = W + (size_t)(k0 + 2 * kp) * ldw + col0 + 4 * nc;
#pragma unroll
    for (int r = 0; r < 8; ++r) { a[r] = *(const f32x4*)(src + (size_t)(8 * r) * ldw); b[r] = *(const f32x4*)(src + (size_t)(8 * r + 1) * ldw); }
#pragma unroll
    for (int r = 0; r < 8; ++r) { float s0 = 1.f, s1 = 1.f; if (kscale) { s0 = kscale[k0 + 8 * r + 2 * kp]; s1 = kscale[k0 + 8 * r + 2 * kp + 1]; }
#pragma unroll
        for (int j = 0; j < 4; ++j) Tt[(4 * nc + j) * 32 + 4 * (r ^ (nc & 7)) + kp] = cvt_pk_bf16(a[r][j] * s0, b[r][j] * s1); }
    LDS_WAIT(); asm volatile("" ::: "memory");
#pragma unroll
    for (int i = 0; i < 8; ++i) { const int n = (lane >> 3) + 8 * i, c = lane & 7;
        const u32x4 v = *(const LAS u32x4*)(Tt + n * 32 + 4 * (c ^ ((n >> 2) & 7)));
        *(u32x4*)(dst + (size_t)n * K + k0 + 8 * c) = v; }
    LDS_WAIT(); asm volatile("" ::: "memory");
}
__device__ __forceinline__ void transpose_item64_fp8(const float* W, int ldw, int col0, int k0, unsigned char* dst, int K, const float* kscale, float wscale, LAS unsigned* Tt, int lane) {
    const int kp = lane >> 4, nc = lane & 15;
    f32x4 x[4][4];
    const float* src = W + (size_t)(k0 + 4 * kp) * ldw + col0 + 4 * nc;
#pragma unroll
    for (int r = 0; r < 4; ++r)
#pragma unroll
        for (int e = 0; e < 4; ++e) x[r][e] = *(const f32x4*)(src + (size_t)(16 * r + e) * ldw);
#pragma unroll
    for (int r = 0; r < 4; ++r) { float sc[4];
#pragma unroll
        for (int e = 0; e < 4; ++e) sc[e] = kscale ? kscale[k0 + 16 * r + 4 * kp + e] * wscale : wscale;
#pragma unroll
        for (int j = 0; j < 4; ++j) Tt[(4 * nc + j) * 20 + 4 * (r ^ ((nc >> 1) & 3)) + kp] = cvt4_fp8(x[r][0][j] * sc[0], x[r][1][j] * sc[1], x[r][2][j] * sc[2], x[r][3][j] * sc[3]); }
    LDS_WAIT(); asm volatile("" ::: "memory");
#pragma unroll
    for (int i = 0; i < 4; ++i) { const int n = (lane >> 2) + 16 * i, c = lane & 3;
        const u32x4 v = *(const LAS u32x4*)(Tt + n * 20 + 4 * (c ^ ((n >> 3) & 3)));
        *(u32x4*)(dst + (size_t)n * K + k0 + 16 * c) = v; }
    LDS_WAIT(); asm volatile("" ::: "memory");
}
__device__ __forceinline__ void p0_prologue(Frame& F) {
    LAS unsigned* scr = (LAS unsigned*)(F.lds + F.wave * 8192);
    const int gw = F.blk * NWAVES + F.wave, NGW = F.G * NWAVES;
    bf16_t* WIN = (bf16_t*)(F.ws + WS_WIN); bf16_t* WOUT = (bf16_t*)(F.ws + WS_WOUT); unsigned char* WGU = F.ws + WS_WGU; unsigned char* WD = F.ws + WS_WD;
    constexpr int I_IN = 16 * 48, I_OUT = 16 * 16, I_E = 384, NITEMS = I_IN + I_OUT + NE * I_E;
    for (int it = gw; it < NITEMS; it += NGW) {
        int r = it;
        if (r < I_IN) { const int kb = r / 48, nb = r % 48, n0 = 64 * nb; transpose_item64(F.w_in, DIN, n0 < 2048 ? n0 : n0 + 8, 64 * kb, WIN + (size_t)n0 * D, D, nullptr, scr, F.lane); continue; }
        r -= I_IN;
        if (r < I_OUT) { const int kb = r / 16, nb = r % 16; transpose_item64(F.w_out, D, 64 * nb, 64 * kb, WOUT + (size_t)(64 * nb) * D, D, nullptr, scr, F.lane); continue; }
        r -= I_OUT;
        const int e = r / I_E; r -= e * I_E;
        if (r < 256) { const bool up = r >= 128; r &= 127; const int kb = r / 8, nb = r % 8, j0 = 64 * nb;
            const float* W = (up ? F.w_up : F.w_gate) + (size_t)e * D * DFF;
            transpose_item64_fp8(W, DFF, j0, 64 * kb, WGU + ((size_t)e * 1024 + 256 * (j0 >> 7) + (up ? 128 : 0) + (j0 & 127)) * D, D, F.norm2_g, FP8_WSCALE, scr, F.lane); continue; }
        r -= 256;
        { const int kb = r / 16, nb = r % 16; transpose_item64_fp8(F.w_down + (size_t)e * DFF * D, D, 64 * nb, 64 * kb, WD + ((size_t)e * 1024 + 64 * nb) * DFF, DFF, nullptr, FP8_WSCALE, scr, F.lane); }
    }
    { const int gt = F.blk * 512 + F.tid, NT_ = F.G * 512; bf16_t* WR = (bf16_t*)(F.ws + WS_WR); bf16_t* WSP = (bf16_t*)(F.ws + WS_WSP);
        for (int i = gt; i < 48 * 1024; i += NT_) { const int n = i >> 10, k = i & 1023; float v = 0.f;
            if (n < 4) v = F.w_rg[k * 4 + n] * F.norm2_g[k]; else if (n < 36) v = F.w_re[k * 32 + (n - 4)] * F.norm2_g[k];
            WR[i] = (bf16_t)f2bf(v); }
        for (int i = gt; i < 8 * 128 * 128; i += NT_) { const int tt = (i >> 7) & 127, s = i & 127; WSP[i] = (bf16_t)f2bf(s <= tt ? F.w_spatial[i] : 0.f); } }
    {
        float wif[4][4][8];
#pragma unroll
        for (int j = 0; j < 4; ++j)
#pragma unroll
            for (int e = 0; e < 4; ++e) { const float* p = F.w_in + (size_t)(256 * j + 4 * F.lane + e) * DIN + 2048; const f32x4 a = *(const f32x4*)p, b = *(const f32x4*)(p + 4);
                wif[j][e][0] = a[0]; wif[j][e][1] = a[1]; wif[j][e][2] = a[2]; wif[j][e][3] = a[3]; wif[j][e][4] = b[0]; wif[j][e][5] = b[1]; wif[j][e][6] = b[2]; wif[j][e][7] = b[3]; }
        f32x4 g1[4];
#pragma unroll
        for (int j = 0; j < 4; ++j) g1[j] = *(const f32x4*)(F.norm1_g + 256 * j + 4 * F.lane);
        bf16_t* XN = (bf16_t*)(F.ws + WS_XN); float* IFP = (float*)(F.ws + WS_IFP);
        for (int m0 = gw; m0 < T; m0 += 2 * NGW) {
            f32x4 vv[2][4];
#pragma unroll
            for (int u = 0; u < 2; ++u) { const f32x4* xr = (const f32x4*)(F.x + (size_t)(m0 + u * NGW) * D) + F.lane;
#pragma unroll
                for (int j = 0; j < 4; ++j) vv[u][j] = xr[64 * j]; }
#pragma unroll
            for (int u = 0; u < 2; ++u) { const int m = m0 + u * NGW; f32x4 (&v)[4] = vv[u]; float s = 0.f;
#pragma unroll
                for (int j = 0; j < 4; ++j) s += (v[j][0] * v[j][0] + v[j][1] * v[j][1]) + (v[j][2] * v[j][2] + v[j][3] * v[j][3]);
                const float rstd = 1.0f / sqrtf(wave_sum(s) * (1.0f / D) + EPS);
                float dot[8];
#pragma unroll
                for (int n = 0; n < 8; ++n) dot[n] = 0.f;
                unsigned long long* o8 = (unsigned long long*)(XN + (size_t)m * D) + F.lane;
#pragma unroll
                for (int j = 0; j < 4; ++j) { v[j] = v[j] * rstd * g1[j];
#pragma unroll
                    for (int e = 0; e < 4; ++e)
#pragma unroll
                        for (int n = 0; n < 8; ++n) dot[n] += v[j][e] * wif[j][e][n];
                    o8[64 * j] = (unsigned long long)cvt_pk_bf16(v[j][0], v[j][1]) | ((unsigned long long)cvt_pk_bf16(v[j][2], v[j][3]) << 32); }
#pragma unroll
                for (int n = 0; n < 8; ++n) dot[n] = wave_sum(dot[n]);
                if (F.lane < 8) { float val = 0.f;
#pragma unroll
                    for (int n = 0; n < 8; ++n) if (F.lane == n) val = dot[n];
                    if (F.lane < 4) val += F.b_igate[F.lane];
                    else { const float f = val + F.b_fgate[F.lane - 4]; val = (f >= 0.f) ? -log1pf(expf(-f)) : (f - log1pf(expf(f))); }
                    IFP[(size_t)m * 8 + F.lane] = val; } }
        }
    }
}

#define BAR_LDS() do { asm volatile("s_waitcnt lgkmcnt(0)" ::: "memory"); __builtin_amdgcn_s_barrier(); asm volatile("" ::: "memory"); } while (0)
constexpr int TS64 = 144;
constexpr int TS128 = 272;
constexpr int CW_OFF = RING_BYTES + 2048;
__device__ __forceinline__ int sw64(int row, int chunk) { return row * TS64 + ((chunk ^ ((row >> 4) & 7)) << 4); }
__device__ __forceinline__ int sw128(int row, int chunk) { return row * TS128 + ((chunk ^ ((row >> 4) & 7)) << 4); }
__device__ __forceinline__ void conv2(const u32x4 (&x)[5], const LAS float* cwp, float scale, float (&o0)[8], float (&o1)[8]) {
    float xr[5][8];
#pragma unroll
    for (int i = 0; i < 5; ++i) unpack8(x[i], xr[i]);
    float cw[4][8];
#pragma unroll
    for (int i = 0; i < 4; ++i) { const f32x4 a = *(const LAS f32x4*)(cwp + i * 256), b = *(const LAS f32x4*)(cwp + i * 256 + 4);
        cw[i][0] = a[0]; cw[i][1] = a[1]; cw[i][2] = a[2]; cw[i][3] = a[3]; cw[i][4] = b[0]; cw[i][5] = b[1]; cw[i][6] = b[2]; cw[i][7] = b[3]; }
#pragma unroll
    for (int j = 0; j < 8; ++j) {
        const float y0 = cw[0][j] * xr[0][j] + cw[1][j] * xr[1][j] + cw[2][j] * xr[2][j] + cw[3][j] * xr[3][j];
        const float y1 = cw[0][j] * xr[1][j] + cw[1][j] * xr[2][j] + cw[2][j] * xr[3][j] + cw[3][j] * xr[4][j];
        o0[j] = silu_f(y0) * scale; o1[j] = silu_f(y1) * scale; }
}
__device__ __forceinline__ void load_conv_w(Frame& F, int h) {
    LAS float* CWL = (LAS float*)(F.lds + CW_OFF);
    for (int i = F.tid; i < 1024; i += 512) { const int tap = i >> 8, c = i & 255; CWL[i] = F.conv_qk[tap * 1024 + (c < 128 ? h * 128 + c : 512 + h * 128 + (c - 128))]; }
}
__device__ __forceinline__ u32x4 pack8(const float (&v)[8]) { u32x4 o; o.x = cvt_pk_bf16(v[0], v[1]); o.y = cvt_pk_bf16(v[2], v[3]); o.z = cvt_pk_bf16(v[4], v[5]); o.w = cvt_pk_bf16(v[6], v[7]); return o; }

struct P2aRegs { u32x4 k[5]; u32x4 v[2]; float ig, lf; };
__device__ __forceinline__ void p2a_load(Frame& F, int bh, int c, P2aRegs& R) {
    const bf16_t* PROJ = (const bf16_t*)(F.ws + WS_PROJ); const float* IFP = (const float*)(F.ws + WS_IFP);
    const int b = bh >> 2, h = bh & 3, trow0 = b * SEQ + c * 64, ch = F.tid & 15, g = F.tid >> 4;
    const int kcol = 512 + h * 128 + 8 * ch, vcol = 1024 + h * 128 + 8 * ch;
#pragma unroll
    for (int i = 0; i < 5; ++i) { const int r = 2 * g - 3 + i; R.k[i] = (u32x4){0u, 0u, 0u, 0u}; if (c * 64 + r >= 0) R.k[i] = *(const u32x4*)(PROJ + (size_t)(trow0 + r) * NPROJ + kcol); }
    R.v[0] = *(const u32x4*)(PROJ + (size_t)(trow0 + 2 * g) * NPROJ + vcol); R.v[1] = *(const u32x4*)(PROJ + (size_t)(trow0 + 2 * g + 1) * NPROJ + vcol);
    R.ig = 0.f; R.lf = 0.f;
    if (F.wave == 0) { const int t = trow0 + F.lane; R.ig = IFP[(size_t)t * 8 + h]; R.lf = IFP[(size_t)t * 8 + 4 + h]; }
}
__device__ __forceinline__ void p2a_compute(Frame& F, int bh, int c, const P2aRegs& R) {
    bf16_t* CST = (bf16_t*)(F.ws + WS_CST); float* NST = (float*)(F.ws + WS_NST); float* CHSC = (float*)(F.ws + WS_CHSC);
    LAS unsigned char* KT = F.lds; LAS unsigned char* VWT = F.lds + 18432; LAS float* WSV = (LAS float*)(F.lds + 36864);
    const LAS float* CWL = (const LAS float*)(F.lds + CW_OFF);
    const int tid = F.tid, lane = F.lane, ch = tid & 15, g = tid >> 4;
    BAR_LDS();
    if (F.wave == 0) {
        float bc = R.lf;
#pragma unroll
        for (int o = 1; o < 64; o <<= 1) { const float v = __shfl_up(bc, o); if (lane >= o) bc += v; }
        const float blast = __shfl(bc, 63);
        const float wst = blast - bc + R.ig;
        const float mloc = wave_max(wst);
        WSV[lane] = __expf(wst - mloc);
        if (lane == 0) { CHSC[(bh * 128 + c) * 2] = blast; CHSC[(bh * 128 + c) * 2 + 1] = mloc; }
    }
    {
        float k0[8], k1[8];
        conv2(R.k, CWL + 128 + 8 * ch, 0.08838834764831845f, k0, k1);
#pragma unroll
        for (int j = 0; j < 8; ++j) *(LAS unsigned*)(KT + sw64(8 * ch + j, g >> 2) + 4 * (g & 3)) = cvt_pk_bf16(k0[j], k1[j]);
    }
    BAR_LDS();
    {
        float v0[8], v1[8]; unpack8(R.v[0], v0); unpack8(R.v[1], v1);
        const float w0 = WSV[2 * g], w1 = WSV[2 * g + 1];
#pragma unroll
        for (int j = 0; j < 8; ++j) *(LAS unsigned*)(VWT + sw64(8 * ch + j, g >> 2) + 4 * (g & 3)) = cvt_pk_bf16(v0[j] * w0, v1[j] * w1);
    }
    BAR_LDS();
    {
        const int fr = lane & 15, fq = lane >> 4, w = F.wave;
        bf16x8 yv[2];
#pragma unroll
        for (int kk = 0; kk < 2; ++kk) yv[kk] = *(const LAS bf16x8*)(VWT + sw64(16 * w + fr, 4 * kk + fq));
        bf16_t* dst = CST + ((size_t)(bh * 128 + c) * 128 + 16 * w + fr) * 128;
#pragma unroll
        for (int dt = 0; dt < 8; ++dt) { f32x4 acc = (f32x4){0.f, 0.f, 0.f, 0.f};
#pragma unroll
            for (int kk = 0; kk < 2; ++kk) { const bf16x8 xk = *(const LAS bf16x8*)(KT + sw64(16 * dt + fr, 4 * kk + fq)); acc = MFMA16(xk, yv[kk], acc); }
            u32x2 o; o.x = cvt_pk_bf16(acc[0], acc[1]); o.y = cvt_pk_bf16(acc[2], acc[3]);
            *(u32x2*)(dst + 16 * dt + 4 * fq) = o; }
    }
    if (tid < 128) { float s = 0.f;
#pragma unroll
        for (int q8 = 0; q8 < 8; ++q8) { float kv[8]; unpack8(*(const LAS u32x4*)(KT + sw64(tid, q8)), kv);
#pragma unroll
            for (int j = 0; j < 8; ++j) s += kv[j] * WSV[q8 * 8 + j]; }
        NST[(size_t)(bh * 128 + c) * 128 + tid] = s; }
}
__device__ __forceinline__ void p2a_block(Frame& F) {
    const int bh = F.blk >> 4, c0 = (F.blk & 15) * 8;
    BAR_LDS(); load_conv_w(F, bh & 3);
    P2aRegs Ra; p2a_load(F, bh, c0, Ra);
#pragma unroll 1
    for (int i = 0; i < 8; ++i) { P2aRegs Rb = Ra; if (i < 7) p2a_load(F, bh, c0 + i + 1, Rb); p2a_compute(F, bh, c0 + i, Ra); Ra = Rb; }
}

struct GmRegs { u32x4 v[2]; u32x4 w[4]; u32x2 u[4]; f32x4 gv[2]; f32x4 go[4]; float bias; };
__device__ __forceinline__ void gm_load(Frame& F, int trow0, int g, GmRegs& R) {
    const bf16_t* PROJ = (const bf16_t*)(F.ws + WS_PROJ); const bf16_t* WSP = (const bf16_t*)(F.ws + WS_WSP);
    const int tid = F.tid, ch = tid & 7, rp = tid >> 3, col = 2560 + 64 * g + 8 * ch, fr = F.lane & 15, fq = F.lane >> 4, tt = 16 * F.wave + fr;
    R.v[0] = *(const u32x4*)(PROJ + (size_t)(trow0 + 2 * rp) * NPROJ + col); R.v[1] = *(const u32x4*)(PROJ + (size_t)(trow0 + 2 * rp + 1) * NPROJ + col);
#pragma unroll
    for (int i = 0; i < 4; ++i) { const int id = tid + 512 * i, row = id >> 4, c16 = id & 15; R.w[i] = *(const u32x4*)(WSP + (size_t)(g * 128 + row) * 128 + c16 * 8); }
#pragma unroll
    for (int ct = 0; ct < 4; ++ct) { R.u[ct] = *(const u32x2*)(PROJ + (size_t)(trow0 + tt) * NPROJ + 2048 + 64 * g + 16 * ct + 4 * fq); R.go[ct] = *(const f32x4*)(F.g_gmlp_out + 64 * g + 16 * ct + 4 * fq); }
    R.gv[0] = *(const f32x4*)(F.g_gmlp_v + 64 * g + 8 * ch); R.gv[1] = *(const f32x4*)(F.g_gmlp_v + 64 * g + 8 * ch + 4);
    R.bias = F.b_spatial[g * 128 + tt];
}
__device__ __forceinline__ void gmlp_tile(Frame& F, int tile) {
    const bf16_t* PROJ = (const bf16_t*)(F.ws + WS_PROJ); bf16_t* Y = (bf16_t*)(F.ws + WS_Y);
    LAS unsigned char* VBT = F.lds; LAS unsigned char* WS_ = F.lds + 17408; LAS float* RST = (LAS float*)(F.lds + 52224);
    const int trow0 = tile * 128, tid = F.tid, lane = F.lane, w = F.wave, fr = lane & 15, fq = lane >> 4;
    GmRegs Ra; gm_load(F, trow0, 0, Ra);
    BAR_LDS();
    if (tid < 128) {
        const float* vq = (const float*)(F.ws + WS_VSQ) + (size_t)(trow0 + tid) * 8; const f32x4 a = *(const f32x4*)vq, b = *(const f32x4*)(vq + 4);
        RST[tid] = 1.0f / sqrtf(((a[0] + a[1]) + (a[2] + a[3]) + (b[0] + b[1]) + (b[2] + b[3])) * (1.0f / 512.0f) + EPS); }
#pragma unroll 1
    for (int g = 0; g < 8; ++g) {
        GmRegs Rb = Ra; if (g < 7) gm_load(F, trow0, g + 1, Rb);
        BAR_LDS();
        {
            const int ch = tid & 7, rp = tid >> 3;
            float v0[8], v1[8]; unpack8(Ra.v[0], v0); unpack8(Ra.v[1], v1);
            const float r0 = RST[2 * rp], r1 = RST[2 * rp + 1];
            const float gg[8] = {Ra.gv[0][0], Ra.gv[0][1], Ra.gv[0][2], Ra.gv[0][3], Ra.gv[1][0], Ra.gv[1][1], Ra.gv[1][2], Ra.gv[1][3]};
#pragma unroll
            for (int j = 0; j < 8; ++j) *(LAS unsigned*)(VBT + sw128(8 * ch + j, rp >> 2) + 4 * (rp & 3)) = cvt_pk_bf16(v0[j] * r0 * gg[j], v1[j] * r1 * gg[j]);
#pragma unroll
            for (int i = 0; i < 4; ++i) { const int id = tid + 512 * i, row = id >> 4, c16 = id & 15; *(LAS u32x4*)(WS_ + row * TS128 + c16 * 16) = Ra.w[i]; }
        }
        BAR_LDS();
        f32x4 acc[4];
#pragma unroll
        for (int ct = 0; ct < 4; ++ct) acc[ct] = (f32x4){0.f, 0.f, 0.f, 0.f};
#pragma unroll
        for (int kk = 0; kk < 4; ++kk) if (32 * kk <= 16 * w + 15) { const bf16x8 yw = *(const LAS bf16x8*)(WS_ + (16 * w + fr) * TS128 + (32 * kk + 8 * fq) * 2);
#pragma unroll
            for (int ct = 0; ct < 4; ++ct) { const bf16x8 xv = *(const LAS bf16x8*)(VBT + sw128(16 * ct + fr, 4 * kk + fq)); acc[ct] = MFMA16(xv, yw, acc[ct]); } }
        const int trow = trow0 + 16 * w + fr;
        float gvv[4][4]; float ss = 0.f;
#pragma unroll
        for (int ct = 0; ct < 4; ++ct) { const float uu[4] = {bflo(Ra.u[ct].x), bfhi(Ra.u[ct].x), bflo(Ra.u[ct].y), bfhi(Ra.u[ct].y)};
#pragma unroll
            for (int j = 0; j < 4; ++j) { gvv[ct][j] = uu[j] * (acc[ct][j] + Ra.bias); ss += gvv[ct][j] * gvv[ct][j]; } }
        ss += __shfl_xor(ss, 16); ss += __shfl_xor(ss, 32);
        const float rs = 1.0f / sqrtf(ss * (1.0f / 64.0f) + EPS);
#pragma unroll
        for (int ct = 0; ct < 4; ++ct) { u32x2 o; o.x = cvt_pk_bf16(gvv[ct][0] * rs * Ra.go[ct][0], gvv[ct][1] * rs * Ra.go[ct][1]); o.y = cvt_pk_bf16(gvv[ct][2] * rs * Ra.go[ct][2], gvv[ct][3] * rs * Ra.go[ct][3]);
            *(u32x2*)(Y + (size_t)trow * D + 512 + 64 * g + 16 * ct + 4 * fq) = o; }
        Ra = Rb;
    }
}

__device__ __forceinline__ void scan_phase(Frame& F) {
    const float* CHSC = (const float*)(F.ws + WS_CHSC); float* MST = (float*)(F.ws + WS_MST); float* NST = (float*)(F.ws + WS_NST);
    unsigned* CST = (unsigned*)(F.ws + WS_CST);
    LAS float* SA = (LAS float*)F.lds; LAS float* SB = SA + 128; LAS float* SCB = SB + 128;
    LAS float* NL = (LAS float*)(F.lds + 4096);
    const int bh = F.blk >> 4, sub = F.blk & 15, tid = F.tid;
    BAR_LDS();
    if (tid < 256) SCB[tid] = CHSC[bh * 256 + tid];
    unsigned* p = CST + (size_t)bh * 128 * 8192 + sub * 512 + tid;
    unsigned ka[16], kb[16];
#pragma unroll
    for (int i = 0; i < 16; ++i) ka[i] = p[(size_t)i * 8192];
    if (sub == 0) {
#pragma unroll
        for (int i = 0; i < 8; ++i) { const int id = tid + 512 * i; *(LAS f32x4*)(NL + id * 4) = *(const f32x4*)(NST + (size_t)bh * 16384 + id * 4); }
    }
    BAR_LDS();
    if (tid == 0) { float m = 0.f;
        for (int c = 0; c < 128; ++c) { const float blast = SCB[2 * c], mloc = SCB[2 * c + 1]; const float mn = fmaxf(blast + m, mloc);
            SA[c] = __expf(blast + m - mn); SB[c] = __expf(mloc - mn); if (sub == 0) MST[bh * 128 + c] = m; m = mn; } }
    BAR_LDS();
    float s0 = 0.f, s1 = 0.f;
#pragma unroll 1
    for (int c0 = 0; c0 < 128; c0 += 32) {
#pragma unroll
        for (int i = 0; i < 16; ++i) kb[i] = p[(size_t)(c0 + 16 + i) * 8192];
#pragma unroll
        for (int i = 0; i < 16; ++i) { p[(size_t)(c0 + i) * 8192] = cvt_pk_bf16(s0, s1); const float a = SA[c0 + i], b = SB[c0 + i]; s0 = a * s0 + b * bflo(ka[i]); s1 = a * s1 + b * bfhi(ka[i]); }
        if (c0 + 32 < 128) {
#pragma unroll
            for (int i = 0; i < 16; ++i) ka[i] = p[(size_t)(c0 + 32 + i) * 8192];
        }
#pragma unroll
        for (int i = 0; i < 16; ++i) { p[(size_t)(c0 + 16 + i) * 8192] = cvt_pk_bf16(s0, s1); const float a = SA[c0 + 16 + i], b = SB[c0 + 16 + i]; s0 = a * s0 + b * bflo(kb[i]); s1 = a * s1 + b * bfhi(kb[i]); }
    }
    if (sub == 0) {
        if (tid < 128) { float s = 0.f;
            for (int c = 0; c < 128; ++c) { const float nl = NL[c * 128 + tid]; NL[c * 128 + tid] = s; s = SA[c] * s + SB[c] * nl; } }
        BAR_LDS();
#pragma unroll
        for (int i = 0; i < 8; ++i) { const int id = tid + 512 * i; *(f32x4*)(NST + (size_t)bh * 16384 + id * 4) = *(const LAS f32x4*)(NL + id * 4); }
    }
    BAR_LDS();
}

struct P4Regs { u32x4 q[5], k[5], v[2], o[2], cs[4]; float ig, lf, mc, n0, n1; };
__device__ __forceinline__ void p4_load(Frame& F, int bh, int c, P4Regs& R) {
    const bf16_t* PROJ = (const bf16_t*)(F.ws + WS_PROJ); const float* IFP = (const float*)(F.ws + WS_IFP);
    const bf16_t* CST = (const bf16_t*)(F.ws + WS_CST); const float* NST = (const float*)(F.ws + WS_NST); const float* MST = (const float*)(F.ws + WS_MST);
    const int b = bh >> 2, h = bh & 3, trow0 = b * SEQ + c * 64, tid = F.tid, ch = tid & 15, g = tid >> 4;
    const int qcol = h * 128 + 8 * ch, kcol = 512 + qcol, vcol = 1024 + qcol;
#pragma unroll
    for (int i = 0; i < 5; ++i) { const int r = 2 * g - 3 + i; R.q[i] = (u32x4){0u, 0u, 0u, 0u}; R.k[i] = (u32x4){0u, 0u, 0u, 0u};
        if (c * 64 + r >= 0) { R.q[i] = *(const u32x4*)(PROJ + (size_t)(trow0 + r) * NPROJ + qcol); R.k[i] = *(const u32x4*)(PROJ + (size_t)(trow0 + r) * NPROJ + kcol); } }
    R.v[0] = *(const u32x4*)(PROJ + (size_t)(trow0 + 2 * g) * NPROJ + vcol); R.v[1] = *(const u32x4*)(PROJ + (size_t)(trow0 + 2 * g + 1) * NPROJ + vcol);
    { const int l = tid >> 3, seg = tid & 7; const bf16_t* op = PROJ + (size_t)(trow0 + l) * NPROJ + 1536 + h * 128 + 16 * seg; R.o[0] = *(const u32x4*)op; R.o[1] = *(const u32x4*)(op + 8); }
    { const bf16_t* src = CST + (size_t)(bh * 128 + c) * 16384;
#pragma unroll
      for (int i = 0; i < 4; ++i) { const int id = tid + 512 * i, row = id >> 4, c16 = id & 15; R.cs[i] = *(const u32x4*)(src + row * 128 + c16 * 8); } }
    R.n0 = 0.f; R.n1 = 0.f; R.ig = 0.f; R.lf = 0.f; R.mc = 0.f;
    if (tid < 64) { const float* ns = NST + (size_t)(bh * 128 + c) * 128 + 2 * tid; R.n0 = ns[0]; R.n1 = ns[1];
        const int t = trow0 + tid; R.ig = IFP[(size_t)t * 8 + h]; R.lf = IFP[(size_t)t * 8 + 4 + h]; R.mc = MST[bh * 128 + c]; }
}
__device__ __forceinline__ void p4_block(Frame& F) {
    bf16_t* Y = (bf16_t*)(F.ws + WS_Y);
    LAS unsigned char* Q = F.lds; LAS unsigned char* QW = F.lds + 17408; LAS unsigned char* KK = F.lds + 34816; LAS unsigned char* VT = F.lds + 52224;
    LAS unsigned char* CS = F.lds + 72960; LAS unsigned char* P = F.lds + 112128; LAS float* SC = (LAS float*)(F.lds + 121344); LAS float* HBUF = (LAS float*)F.lds;
    LAS float* S_BC = SC, * S_A = SC + 64, * S_MT = SC + 128, * S_WI = SC + 192, * S_EN = SC + 256, * S_NQ = SC + 320;
    const LAS float* CWL = (const LAS float*)(F.lds + CW_OFF);
    const int bh = F.blk >> 4, c0 = (F.blk & 15) * 8, b = bh >> 2, h = bh & 3;
    const int tid = F.tid, lane = F.lane, w = F.wave, fr = lane & 15, fq = lane >> 4, ch = tid & 15, g = tid >> 4;
    BAR_LDS(); load_conv_w(F, h);
    float gm[16];
    { const int seg = tid & 7;
#pragma unroll
      for (int j4 = 0; j4 < 4; ++j4) { const f32x4 t4 = *(const f32x4*)(F.g_mlstm_out + h * 128 + 16 * seg + 4 * j4); gm[4 * j4] = t4[0]; gm[4 * j4 + 1] = t4[1]; gm[4 * j4 + 2] = t4[2]; gm[4 * j4 + 3] = t4[3]; } }
    P4Regs R; p4_load(F, bh, c0, R);
#pragma unroll 1
    for (int ci = 0; ci < 8; ++ci) {
        const int c = c0 + ci, trow0 = b * SEQ + c * 64;
        BAR_LDS();
        if (w == 0) {
            float bc = R.lf;
#pragma unroll
            for (int o = 1; o < 64; o <<= 1) { const float v = __shfl_up(bc, o); if (lane >= o) bc += v; }
            const float a = R.ig - bc; float pm = a;
#pragma unroll
            for (int o = 1; o < 64; o <<= 1) { const float v = __shfl_up(pm, o); if (lane >= o) pm = fmaxf(pm, v); }
            const float inter = bc + R.mc, mt = fmaxf(inter, bc + pm);
            S_BC[lane] = bc; S_A[lane] = a; S_MT[lane] = mt; S_WI[lane] = __expf(inter - mt); S_EN[lane] = __expf(-mt);
        }
        float q0[8], q1[8];
        conv2(R.q, CWL + 8 * ch, 1.0f, q0, q1);
        {
            float k0[8], k1[8];
            conv2(R.k, CWL + 128 + 8 * ch, 0.08838834764831845f, k0, k1);
            *(LAS u32x4*)(KK + (2 * g) * TS128 + 16 * ch) = pack8(k0); *(LAS u32x4*)(KK + (2 * g + 1) * TS128 + 16 * ch) = pack8(k1);
            *(LAS u32x4*)(Q + (2 * g) * TS128 + 16 * ch) = pack8(q0); *(LAS u32x4*)(Q + (2 * g + 1) * TS128 + 16 * ch) = pack8(q1);
        }
        {
            float v0[8], v1[8]; unpack8(R.v[0], v0); unpack8(R.v[1], v1);
#pragma unroll
            for (int j = 0; j < 8; ++j) *(LAS unsigned*)(VT + sw64(8 * ch + j, g >> 2) + 4 * (g & 3)) = cvt_pk_bf16(v0[j], v1[j]);
            *(LAS unsigned*)(VT + (128 + (tid >> 5)) * TS64 + 4 * (tid & 31)) = (tid < 32) ? 0x3F803F80u : 0u;
        }
        {
#pragma unroll
            for (int i = 0; i < 4; ++i) { const int id = tid + 512 * i, row = id >> 4, c16 = id & 15; *(LAS u32x4*)(CS + row * TS128 + c16 * 16) = R.cs[i]; }
            if (tid < 64) *(LAS unsigned*)(CS + 128 * TS128 + 4 * tid) = cvt_pk_bf16(R.n0, R.n1);
            else if (tid < 64 + 240) { const int id = tid - 64, row = 129 + (id >> 4), c16 = id & 15; *(LAS u32x4*)(CS + row * TS128 + c16 * 16) = (u32x4){0u, 0u, 0u, 0u}; }
        }
        const u32x4 oa = R.o[0], ob = R.o[1];
        if (ci < 7) p4_load(F, bh, c + 1, R);
        BAR_LDS();
        {
            const float w0 = S_WI[2 * g], w1 = S_WI[2 * g + 1];
#pragma unroll
            for (int j = 0; j < 8; ++j) { q0[j] *= w0; q1[j] *= w1; }
            *(LAS u32x4*)(QW + (2 * g) * TS128 + 16 * ch) = pack8(q0); *(LAS u32x4*)(QW + (2 * g + 1) * TS128 + 16 * ch) = pack8(q1);
        }
        {
            const int lt = w >> 1; const int l = 16 * lt + fr; const float bl = S_BC[l], ml = S_MT[l];
#pragma unroll
            for (int si = 0; si < 2; ++si) { const int st = 2 * (w & 1) + si; f32x4 acc = (f32x4){0.f, 0.f, 0.f, 0.f};
                if (st <= lt) {
#pragma unroll
                    for (int kk = 0; kk < 4; ++kk) { const bf16x8 xk = *(const LAS bf16x8*)(KK + (16 * st + fr) * TS128 + (32 * kk + 8 * fq) * 2); const bf16x8 yq = *(const LAS bf16x8*)(Q + l * TS128 + (32 * kk + 8 * fq) * 2); acc = MFMA16(xk, yq, acc); }
                }
                float pv[4];
#pragma unroll
                for (int j = 0; j < 4; ++j) { const int s = 16 * st + 4 * fq + j; pv[j] = (s <= l) ? acc[j] * __expf(bl + S_A[s] - ml) : 0.f; }
                u32x2 o; o.x = cvt_pk_bf16(pv[0], pv[1]); o.y = cvt_pk_bf16(pv[2], pv[3]);
                *(LAS u32x2*)(P + l * TS64 + (16 * st + 4 * fq) * 2) = o; }
        }
        BAR_LDS();
        f32x4 acc[4], accx = (f32x4){0.f, 0.f, 0.f, 0.f};
#pragma unroll
        for (int lt = 0; lt < 4; ++lt) { acc[lt] = (f32x4){0.f, 0.f, 0.f, 0.f};
#pragma unroll
            for (int kk = 0; kk < 2; ++kk) { const bf16x8 xv = *(const LAS bf16x8*)(VT + sw64(16 * w + fr, 4 * kk + fq)); const bf16x8 yp = *(const LAS bf16x8*)(P + (16 * lt + fr) * TS64 + (32 * kk + 8 * fq) * 2); acc[lt] = MFMA16(xv, yp, acc[lt]); }
#pragma unroll
            for (int kk = 0; kk < 4; ++kk) { const bf16x8 xc = *(const LAS bf16x8*)(CS + (16 * w + fr) * TS128 + (32 * kk + 8 * fq) * 2); const bf16x8 yq = *(const LAS bf16x8*)(QW + (16 * lt + fr) * TS128 + (32 * kk + 8 * fq) * 2); acc[lt] = MFMA16(xc, yq, acc[lt]); } }
        if (w < 4) {
#pragma unroll
            for (int kk = 0; kk < 2; ++kk) { const bf16x8 xv = *(const LAS bf16x8*)(VT + (128 + fr) * TS64 + (32 * kk + 8 * fq) * 2); const bf16x8 yp = *(const LAS bf16x8*)(P + (16 * w + fr) * TS64 + (32 * kk + 8 * fq) * 2); accx = MFMA16(xv, yp, accx); }
#pragma unroll
            for (int kk = 0; kk < 4; ++kk) { const bf16x8 xc = *(const LAS bf16x8*)(CS + (128 + fr) * TS128 + (32 * kk + 8 * fq) * 2); const bf16x8 yq = *(const LAS bf16x8*)(QW + (16 * w + fr) * TS128 + (32 * kk + 8 * fq) * 2); accx = MFMA16(xc, yq, accx); }
            if (fq == 0) S_NQ[16 * w + fr] = accx[0];
        }
        BAR_LDS();
#pragma unroll
        for (int lt = 0; lt < 4; ++lt) *(LAS f32x4*)(HBUF + (16 * lt + fr) * 132 + 16 * w + 4 * fq) = acc[lt];
        BAR_LDS();
        {
            const int l = tid >> 3, seg = tid & 7, t = trow0 + l;
            const float den = 1.0f / fmaxf(fabsf(S_NQ[l]), S_EN[l]);
            float ov[16]; { float t8[8]; unpack8(oa, t8);
#pragma unroll
                for (int j = 0; j < 8; ++j) ov[j] = t8[j];
                unpack8(ob, t8);
#pragma unroll
                for (int j = 0; j < 8; ++j) ov[8 + j] = t8[j]; }
            float hv[16]; float ss = 0.f;
#pragma unroll
            for (int j4 = 0; j4 < 4; ++j4) { const f32x4 nv = *(const LAS f32x4*)(HBUF + l * 132 + 16 * seg + 4 * j4);
#pragma unroll
                for (int j = 0; j < 4; ++j) { const float x = nv[j] * den * ov[4 * j4 + j]; hv[4 * j4 + j] = x; ss += x * x; } }
            ss += __shfl_xor(ss, 1); ss += __shfl_xor(ss, 2); ss += __shfl_xor(ss, 4);
            const float rs = 1.0f / sqrtf(ss * (1.0f / 128.0f) + EPS);
#pragma unroll
            for (int j = 0; j < 16; ++j) hv[j] *= rs * gm[j];
            u32x4 o; o.x = cvt_pk_bf16(hv[0], hv[1]); o.y = cvt_pk_bf16(hv[2], hv[3]); o.z = cvt_pk_bf16(hv[4], hv[5]); o.w = cvt_pk_bf16(hv[6], hv[7]);
            *(u32x4*)(Y + (size_t)t * D + h * 128 + 16 * seg) = o;
            o.x = cvt_pk_bf16(hv[8], hv[9]); o.y = cvt_pk_bf16(hv[10], hv[11]); o.z = cvt_pk_bf16(hv[12], hv[13]); o.w = cvt_pk_bf16(hv[14], hv[15]);
            *(u32x4*)(Y + (size_t)t * D + h * 128 + 16 * seg + 8) = o;
        }
    }
    BAR_LDS();
}

constexpr int WR_STR = 2064;
__device__ __forceinline__ void router_phase(Frame& F) {
    const bf16_t* HB = (const bf16_t*)(F.ws + WS_HB); const bf16_t* WR = (const bf16_t*)(F.ws + WS_WR); const float* HSQ = (const float*)(F.ws + WS_HSQ);
    unsigned* LIST = (unsigned*)(F.ws + WS_LIST); float* SRSTD = (float*)(F.ws + WS_SRSTD); float* SW = (float*)(F.ws + WS_SW); unsigned* GCNT = (unsigned*)(F.ws + WS_CTL) + CW_GCNT;
    LAS unsigned char* WRL = F.lds; LAS float* LOG = (LAS float*)(F.lds + 99072); LAS unsigned* CNT = (LAS unsigned*)(F.lds + 99072 + 26624); LAS unsigned* BASE = CNT + 32;
    const int tid = F.tid, lane = F.lane, w = F.wave, fr = lane & 15, fq = lane >> 4;
    for (int tb = F.blk; tb < T / 128; tb += F.G) {
        __syncthreads();
#pragma unroll
        for (int i = 0; i < 12; ++i) { const int id = tid + 512 * i, row = id >> 7, c16 = id & 127; *(LAS u32x4*)(WRL + row * WR_STR + c16 * 16) = *(const u32x4*)(WR + (size_t)row * 1024 + c16 * 8); }
        if (tid < 32) CNT[tid] = 0u;
        __syncthreads();
        const int t0 = tb * 128 + w * 16;
        f32x4 acc[3];
#pragma unroll
        for (int nt = 0; nt < 3; ++nt) acc[nt] = (f32x4){0.f, 0.f, 0.f, 0.f};
        const bf16_t* hrow = HB + (size_t)(t0 + fr) * D + 8 * fq;
#pragma unroll 8
        for (int kk = 0; kk < 32; ++kk) { const bf16x8 y = *(const bf16x8*)(hrow + 32 * kk);
#pragma unroll
            for (int nt = 0; nt < 3; ++nt) { const bf16x8 x = *(const LAS bf16x8*)(WRL + (16 * nt + fr) * WR_STR + (32 * kk + 8 * fq) * 2); acc[nt] = MFMA16(x, y, acc[nt]); } }
        LAS float* lg = LOG + w * (16 * 52);
#pragma unroll
        for (int nt = 0; nt < 3; ++nt) *(LAS f32x4*)(lg + fr * 52 + 16 * nt + 4 * fq) = acc[nt];
        __syncthreads();
        int e0 = 0, e1 = 0; unsigned r0 = 0, r1 = 0; float w0 = 0.f, w1 = 0.f, rstd = 0.f; const int t = t0 + lane;
        if (lane < 16) {
            float ss = 0.f;
#pragma unroll
            for (int i = 0; i < 4; ++i) { const f32x4 v = *(const f32x4*)(HSQ + (size_t)t * 16 + 4 * i); ss += (v[0] + v[1]) + (v[2] + v[3]); }
            rstd = 1.0f / sqrtf(ss * (1.0f / D) + EPS);
            const LAS float* L = lg + lane * 52;
            float gl[4]; int gs = 0; float gmx;
#pragma unroll
            for (int i = 0; i < 4; ++i) gl[i] = L[i] * rstd + F.b_rg[i];
            gmx = gl[0];
#pragma unroll
            for (int i = 1; i < 4; ++i) if (gl[i] > gmx) { gmx = gl[i]; gs = i; }
            float gsum = 0.f;
#pragma unroll
            for (int i = 0; i < 4; ++i) gsum += __expf(gl[i] - gmx);
            const float pg = 1.0f / gsum;
            float el[8];
#pragma unroll
            for (int i = 0; i < 8; ++i) el[i] = L[4 + gs * 8 + i] * rstd + F.b_re[gs * 8 + i];
            int i0 = 0; float m0 = el[0];
#pragma unroll
            for (int i = 1; i < 8; ++i) if (el[i] > m0) { m0 = el[i]; i0 = i; }
            int i1 = (i0 == 0) ? 1 : 0; float m1 = (i0 == 0) ? el[1] : el[0];
#pragma unroll
            for (int i = 1; i < 8; ++i) if (i != i0 && el[i] > m1) { m1 = el[i]; i1 = i; }
            const float ex = __expf(m1 - m0);
            w0 = pg / (1.0f + ex); w1 = pg * ex / (1.0f + ex);
            e0 = gs * 8 + i0; e1 = gs * 8 + i1;
            r0 = atomicAdd((unsigned*)&CNT[e0], 1u); r1 = atomicAdd((unsigned*)&CNT[e1], 1u);
        }
        __syncthreads();
        if (tid < 32) BASE[tid] = __hip_atomic_fetch_add(GCNT + tid, CNT[tid], __ATOMIC_RELAXED, __HIP_MEMORY_SCOPE_AGENT);
        __syncthreads();
        if (lane < 16) {
            const unsigned i0 = (unsigned)e0 * CAP + BASE[e0] + r0, i1 = (unsigned)e1 * CAP + BASE[e1] + r1;
            LIST[i0] = 2u * t; SRSTD[i0] = rstd; SW[i0] = w0;
            LIST[i1] = 2u * t + 1u; SRSTD[i1] = rstd; SW[i1] = w1;
        }
    }
}

__device__ __forceinline__ void unpack8_fp8(const u32x2 r, float (&v)[8]) {
    const f32x2 a = __builtin_amdgcn_cvt_pk_f32_fp8((int)r.x, false), b = __builtin_amdgcn_cvt_pk_f32_fp8((int)r.x, true), c = __builtin_amdgcn_cvt_pk_f32_fp8((int)r.y, false), d = __builtin_amdgcn_cvt_pk_f32_fp8((int)r.y, true);
    v[0] = a[0]; v[1] = a[1]; v[2] = b[0]; v[3] = b[1]; v[4] = c[0]; v[5] = c[1]; v[6] = d[0]; v[7] = d[1];
}
__device__ __forceinline__ void final_phase(Frame& F) {
    const bf16_t* HB = (const bf16_t*)(F.ws + WS_HB); const unsigned char* YE = F.ws + WS_YE;
    const int gw = F.blk * NWAVES + F.wave, NGW = F.G * NWAVES, lane = F.lane;
    f32x4 fg[4];
#pragma unroll
    for (int i = 0; i < 4; ++i) fg[i] = *(const f32x4*)(F.final_g + 16 * lane + 4 * i);
    for (int m0 = gw; m0 < T; m0 += 2 * NGW) {
        u32x4 ra[2][2], rb[2], rc[2];
#pragma unroll
        for (int u = 0; u < 2; ++u) { const int m = m0 + u * NGW;
            ra[u][0] = *(const u32x4*)(HB + (size_t)m * D + 16 * lane); ra[u][1] = *(const u32x4*)(HB + (size_t)m * D + 16 * lane + 8);
            rb[u] = *(const u32x4*)(YE + (size_t)(2 * m) * D + 16 * lane); rc[u] = *(const u32x4*)(YE + (size_t)(2 * m + 1) * D + 16 * lane); }
#pragma unroll
        for (int u = 0; u < 2; ++u) { const int m = m0 + u * NGW; float v[16]; float s = 0.f;
#pragma unroll
            for (int hh = 0; hh < 2; ++hh) { float a[8], b[8], c[8]; unpack8(ra[u][hh], a);
                unpack8_fp8(hh ? (u32x2){rb[u].z, rb[u].w} : (u32x2){rb[u].x, rb[u].y}, b); unpack8_fp8(hh ? (u32x2){rc[u].z, rc[u].w} : (u32x2){rc[u].x, rc[u].y}, c);
#pragma unroll
                for (int j = 0; j < 8; ++j) { const float x = a[j] + (b[j] + c[j]) * (1.0f / FP8_YSCALE); v[8 * hh + j] = x; s += x * x; } }
            const float rstd = 1.0f / sqrtf(wave_sum(s) * (1.0f / D) + EPS);
            f32x4* o = (f32x4*)(F.out + (size_t)m * D + 16 * lane);
#pragma unroll
            for (int i = 0; i < 4; ++i) { f32x4 r; r[0] = v[4 * i] * rstd * fg[i][0]; r[1] = v[4 * i + 1] * rstd * fg[i][1]; r[2] = v[4 * i + 2] * rstd * fg[i][2]; r[3] = v[4 * i + 3] * rstd * fg[i][3]; o[i] = r; } }
    }
}

#ifndef MK_DBG_TELE
#define MK_DBG_TELE 0
#endif
constexpr int CW_TELE = 128;
__device__ __forceinline__ void dbg_count_bf16(Frame& F, const bf16_t* p, size_t n, int slot) {
    unsigned bad = 0; const size_t gt = (size_t)F.blk * 512 + F.tid, NT_ = (size_t)F.G * 512;
    for (size_t i = gt; i < n; i += NT_) { const float v = bflo((unsigned)p[i]); if (!(fabsf(v) < 1.0e6f)) ++bad; }
    if (bad) atomicAdd((unsigned*)(F.ws + WS_CTL) + CW_TELE + slot, bad);
}
__device__ __forceinline__ void dbg_count_f32(Frame& F, const float* p, size_t n, int slot) {
    unsigned bad = 0; const size_t gt = (size_t)F.blk * 512 + F.tid, NT_ = (size_t)F.G * 512;
    for (size_t i = gt; i < n; i += NT_) { const float v = p[i]; if (!(fabsf(v) < 1.0e6f)) ++bad; }
    if (bad) atomicAdd((unsigned*)(F.ws + WS_CTL) + CW_TELE + slot, bad);
}
__device__ __forceinline__ void dbg_check_phase(Frame& F, int p) {
    if (p == 0) { dbg_count_bf16(F, (const bf16_t*)(F.ws + WS_XN), (size_t)T * D, 1); dbg_count_f32(F, (const float*)(F.ws + WS_IFP), (size_t)T * 8, 2); dbg_count_bf16(F, (const bf16_t*)(F.ws + WS_WIN), (size_t)NPROJ * D, 3);
                  dbg_count_bf16(F, (const bf16_t*)(F.ws + WS_WGU), (size_t)NE * 1024 * D, 4); dbg_count_bf16(F, (const bf16_t*)(F.ws + WS_WD), (size_t)NE * 1024 * DFF, 5); dbg_count_bf16(F, (const bf16_t*)(F.ws + WS_WOUT), (size_t)D * D, 6); }
    if (p == 1) dbg_count_bf16(F, (const bf16_t*)(F.ws + WS_PROJ), (size_t)T * NPROJ, 7);
    if (p == 2) { dbg_count_bf16(F, (const bf16_t*)(F.ws + WS_CST), (size_t)2048 * 16384, 8); dbg_count_f32(F, (const float*)(F.ws + WS_NST), (size_t)2048 * 128, 9); dbg_count_f32(F, (const float*)(F.ws + WS_CHSC), (size_t)4096, 10); }
    if (p == 3) { dbg_count_bf16(F, (const bf16_t*)(F.ws + WS_CST), (size_t)2048 * 16384, 11); dbg_count_f32(F, (const float*)(F.ws + WS_NST), (size_t)2048 * 128, 12); dbg_count_f32(F, (const float*)(F.ws + WS_MST), (size_t)2048, 13); }
    if (p == 4) dbg_count_bf16(F, (const bf16_t*)(F.ws + WS_Y), (size_t)T * D, 14);
    if (p == 5) { dbg_count_bf16(F, (const bf16_t*)(F.ws + WS_HB), (size_t)T * D, 15); dbg_count_f32(F, (const float*)(F.ws + WS_HSQ), (size_t)T * 16, 16); }
}
__device__ __forceinline__ void dbg_msq(Frame& F, size_t wsoff, int isf32, int rows, int ld, int c0, int nc) {
    float acc = 0.f; const size_t gt = (size_t)F.blk * 512 + F.tid, NT_ = (size_t)F.G * 512, n = (size_t)rows * nc;
    for (size_t i = gt; i < n; i += NT_) { const size_t r = i / nc, c = c0 + i % nc; float v = isf32 ? ((const float*)(F.ws + wsoff))[r * ld + c] : bflo((unsigned)((const bf16_t*)(F.ws + wsoff))[r * ld + c]);
        if (!(fabsf(v) < 1.0e6f)) v = 1.0e6f; acc += v * v; }
    acc = wave_sum(acc);
    if (F.lane == 0) atomicAdd((float*)(F.ws + WS_CTL) + CW_TELE + 40, acc / (float)n);
}
__device__ __forceinline__ void dbg_msq_phase(Frame& F, int p) {
    const int m = MK_DBG_TELE - 100;
    if (p == 0 && m == 0) dbg_msq(F, WS_XN, 0, T, D, 0, D);
    if (p == 0 && m == 1) dbg_msq(F, WS_WIN, 0, NPROJ, D, 0, D);
    if (p == 0 && m == 2) dbg_msq(F, WS_IFP, 1, T, 8, 0, 8);
    if (p == 1 && m == 3) dbg_msq(F, WS_PROJ, 0, T, NPROJ, 0, 1024);
    if (p == 1 && m == 4) dbg_msq(F, WS_PROJ, 0, T, NPROJ, 1024, 512);
    if (p == 1 && m == 5) dbg_msq(F, WS_PROJ, 0, T, NPROJ, 1536, 512);
    if (p == 1 && m == 6) dbg_msq(F, WS_PROJ, 0, T, NPROJ, 2048, 1024);
    if (p == 2 && m == 7) dbg_msq(F, WS_CST, 0, 2048 * 128, 128, 0, 128);
    if (p == 2 && m == 8) dbg_msq(F, WS_Y, 0, T, D, 512, 512);
    if (p == 3 && m == 9) dbg_msq(F, WS_CST, 0, 2048 * 128, 128, 0, 128);
    if (p == 4 && m == 10) dbg_msq(F, WS_Y, 0, T, D, 0, 512);
    if (p == 5 && m == 11) dbg_msq(F, WS_HB, 0, T, D, 0, D);
    if (p == 2 && m == 13) dbg_msq(F, WS_NST, 1, 2048, 128, 0, 128);
    if (p == 2 && m == 14) dbg_msq(F, WS_CHSC, 1, 2048, 2, 0, 2);
}
__device__ __forceinline__ void dbg_tele_out(Frame& F) {
    const unsigned* tc = (const unsigned*)(F.ws + WS_CTL) + CW_TELE; float val = 0.5f;
    if (MK_DBG_TELE == 1) { for (int sl = 1; sl < 32; ++sl) { const unsigned c = tc[sl]; if (c) { val = 100.0f * sl + (float)(31 - __builtin_clz(c)); break; } } }
    else if (MK_DBG_TELE >= 100) { val = 1000.0f * ((const float*)tc)[40]; }
    else { val = (float)tc[MK_DBG_TELE]; }
    const size_t gt = (size_t)F.blk * 512 + F.tid, NT_ = (size_t)F.G * 512;
    for (size_t i = gt; i < (size_t)T * D; i += NT_) F.out[i] = val;
}
constexpr int NPHASES = 10;
#ifndef MK_DBG_NPH
#define MK_DBG_NPH 10
#endif
__global__ void __launch_bounds__(NWAVES * 64, 2) mk_fwd(Args args) {
    extern __shared__ __attribute__((aligned(16))) unsigned char lds_raw[];
    Frame F;
    F.lds = (LAS unsigned char*)lds_raw;
    F.tid = threadIdx.x; F.lane = F.tid & 63; F.wave = __builtin_amdgcn_readfirstlane(F.tid >> 6); F.G = gridDim.x; F.blk = blockIdx.x;
    F.x = args.in[0]; F.norm1_g = args.in[1]; F.w_in = args.in[2]; F.conv_qk = args.in[3]; F.b_igate = args.in[4]; F.b_fgate = args.in[5]; F.g_mlstm_out = args.in[6];
    F.g_gmlp_v = args.in[7]; F.w_spatial = args.in[8]; F.b_spatial = args.in[9]; F.g_gmlp_out = args.in[10]; F.w_out = args.in[11]; F.norm2_g = args.in[12];
    F.w_rg = args.in[13]; F.b_rg = args.in[14]; F.w_re = args.in[15]; F.b_re = args.in[16]; F.w_gate = args.in[17]; F.w_up = args.in[18]; F.w_down = args.in[19]; F.final_g = args.in[20];
    F.out = args.out; F.ws = args.ws;
    volatile LAS unsigned* MISC = (volatile LAS unsigned*)(F.lds + MISC_OFF);
    for (int u = F.tid; u < (LDS_BYTES - TBL_OFF) / 4; u += NWAVES * 64) ((LAS unsigned*)(F.lds + TBL_OFF))[u] = 0u;
    __syncthreads();
    unsigned* ctl = (unsigned*)(F.ws + WS_CTL);
    XcdBarrier bar; bar.bar = ctl + CW_BAR; bar.x = 0; bar.st = nullptr;
    if (MK_N_LAUNCHES == 1) bar = xcd_barrier_post(ctl + CW_BAR, MISC + 8);
    const int lo = args.ph_lo, hi = args.ph_hi;
#define IN(k) (lo <= (k) && (k) < hi)
#define SEAM(k) do { if (IN(k) && IN((k) + 1)) xcd_barrier(bar); } while (0)

    if (IN(0)) { p0_prologue(F); } SEAM(0);
    if (IN(1)) {
        pg8::Gemm g{(const bf16_t*)(F.ws + WS_XN), (const bf16_t*)(F.ws + WS_WIN), T, NPROJ, D, nullptr}; pg8::StaticOrder S; S.init(T, NPROJ, F.G, F.blk);
        pg8::EpiP1 E{(bf16_t*)(F.ws + WS_PROJ), (float*)(F.ws + WS_VSQ)};
        pg8::gemm_phase<pg8::EpiP1, pg8::StaticOrder, false>(F.lds, g, S, E);
    } SEAM(1);
    if (IN(2)) {
        p2a_block(F); gmlp_tile(F, F.blk); BAR_LDS();
    } SEAM(2);
    if (IN(3)) { scan_phase(F); } SEAM(3);
    if (IN(4)) { p4_block(F); } SEAM(4);
    if (IN(5)) {
        pg8::Gemm g{(const bf16_t*)(F.ws + WS_Y), (const bf16_t*)(F.ws + WS_WOUT), T, D, D, nullptr}; pg8::StaticOrder S; S.init(T, D, F.G, F.blk);
        pg8::EpiP5 E{F.x, (bf16_t*)(F.ws + WS_HB), (float*)(F.ws + WS_HSQ), F.ws + WS_HB8};
        pg8::gemm_phase<pg8::EpiP5, pg8::StaticOrder, false>(F.lds, g, S, E);
    } SEAM(5);
    if (IN(6)) { router_phase(F); } SEAM(6);
    if (IN(7) || IN(8)) {
        LAS int* tbl = (LAS int*)(F.lds + TBL_OFF);
        __syncthreads();
        if (F.tid == 0) { int acc = 0; const unsigned* GCNT = ctl + CW_GCNT;
            for (int e = 0; e < NE; ++e) { const int cnt = (int)__hip_atomic_load(GCNT + e, __ATOMIC_RELAXED, __HIP_MEMORY_SCOPE_AGENT); tbl[e] = acc; tbl[33 + e] = cnt; acc += (cnt + 255) >> 8; }
            tbl[32] = acc; }
        __syncthreads();
        if (IN(7)) {
            pg8::Gemm g{(const bf16_t*)(F.ws + WS_HB8), (const bf16_t*)(F.ws + WS_WGU), 0, 0, D / 2, (const unsigned*)(F.ws + WS_LIST)};
            pg8::MoeOrder S{tbl, tbl[32] * 4, F.G, F.blk};
            pg8::EpiGU E{(const float*)(F.ws + WS_SRSTD), F.ws + WS_HID};
            pg8::gemm_phase<pg8::EpiGU, pg8::MoeOrder, true, true>(F.lds, g, S, E);
        }
        SEAM(7);
        if (IN(8)) {
            pg8::Gemm g{(const bf16_t*)(F.ws + WS_HID), (const bf16_t*)(F.ws + WS_WD), 0, 0, DFF / 2, nullptr};
            pg8::MoeOrder S{tbl, tbl[32] * 4, F.G, F.blk};
            pg8::EpiDown E{(const unsigned*)(F.ws + WS_LIST), (const float*)(F.ws + WS_SW), F.ws + WS_YE};
            pg8::gemm_phase<pg8::EpiDown, pg8::MoeOrder, false, true>(F.lds, g, S, E);
        }
    }
    SEAM(8);
    if (IN(9)) { final_phase(F); }
    if (lo >= 20 && lo < 30) { if (MK_DBG_TELE >= 100) dbg_msq_phase(F, lo - 20); else dbg_check_phase(F, lo - 20); }
    if (lo == 30) dbg_tele_out(F);
#undef IN
#undef SEAM
}

extern "C" void kernel_launch(void* const* d_in, const int* in_sizes, int n_in, void* d_out, int out_size, void* d_ws, size_t ws_size, hipStream_t stream) {
    static int grid = 0;
    if (grid == 0) {
        if (n_in != 21 || out_size != T * D || ws_size < WS_END) { fprintf(stderr, "kernel_launch: unexpected shapes (n_in %d, out %d, ws %zu)\n", n_in, out_size, ws_size); grid = -1; return; }
        int dev = 0, cus = 0, per_cu = 0;
        if (hipGetDevice(&dev) != hipSuccess || hipDeviceGetAttribute(&cus, hipDeviceAttributeMultiprocessorCount, dev) != hipSuccess) { grid = -1; return; }
        if (hipFuncSetAttribute((const void*)mk_fwd, hipFuncAttributeMaxDynamicSharedMemorySize, LDS_BYTES) != hipSuccess) { fprintf(stderr, "kernel_launch: hipFuncSetAttribute failed\n"); grid = -1; return; }
        if (hipOccupancyMaxActiveBlocksPerMultiprocessor(&per_cu, (const void*)mk_fwd, NWAVES * 64, LDS_BYTES) != hipSuccess || per_cu < 1) { fprintf(stderr, "kernel_launch: occupancy query says %d blocks/CU\n", per_cu); (void)hipGetLastError(); grid = -1; return; }
        if (cus < 256) { fprintf(stderr, "kernel_launch: needs 256 CUs (got %d)\n", cus); grid = -1; return; }
        grid = 256;
    }
    if (grid < 0) return;
    (void)hipMemsetAsync((char*)d_ws + WS_CTL, 0, CTL_ZERO_BYTES, stream);
    Args a{};
    for (int i = 0; i < 21; ++i) a.in[i] = (const float*)d_in[i];
    a.out = (float*)d_out; a.ws = (unsigned char*)d_ws;
    if (MK_N_LAUNCHES == 1) {
        a.ph_lo = 0; a.ph_hi = NPHASES;
        hipLaunchKernelGGL(mk_fwd, dim3(grid), dim3(NWAVES * 64), LDS_BYTES, stream, a);
    } else {
        for (int p = 0; p < MK_DBG_NPH; ++p) { a.ph_lo = p; a.ph_hi = p + 1; hipLaunchKernelGGL(mk_fwd, dim3(grid), dim3(NWAVES * 64), LDS_BYTES, stream, a);
            if (MK_DBG_TELE) { a.ph_lo = 20 + p; a.ph_hi = 21 + p; hipLaunchKernelGGL(mk_fwd, dim3(grid), dim3(NWAVES * 64), LDS_BYTES, stream, a); } }
        if (MK_DBG_TELE) { a.ph_lo = 30; a.ph_hi = 31; hipLaunchKernelGGL(mk_fwd, dim3(grid), dim3(NWAVES * 64), LDS_BYTES, stream, a); }
    }
}
```
